# Optimizing an MI355X kernel written in HIP

```python
import jax, jax.numpy as jnp
from jax import lax
import numpy as np

D_MODEL = 1024
BATCH = 8
SEQ = 2048
DEPTH = 1
DEC_BATCH = 16
DEC_SEQ = 2048
PAST_LEN = 128

HEAD_DIM = 64
N_HEADS_A = 8
N_HEADS_B = 8
WIDTH_A = N_HEADS_A * HEAD_DIM
WIDTH_B = N_HEADS_B * HEAD_DIM
DILATED_PATTERNS = ((128, 1), (512, 4), (2048, 16))
ROPE_THETA = 500000.0
ROPE_DIM = HEAD_DIM // 4
GRID_W = 64
NA_ROWS_MAX = 8
NA_COLS = 16
NA_COL_BLOCK = NA_COLS
NA_COL_SPAN = 2 * NA_COLS
RPB_ROWS = 2 * NA_ROWS_MAX - 1
RPB_COLS = 2 * NA_COLS - 1
D_FF = 2816
CONV_W = 3
EPS = 1e-6
NEG_INF = -1e30
IN_SPLITS = (WIDTH_A, 2 * WIDTH_A, 3 * WIDTH_A, 3 * WIDTH_A + WIDTH_B,
             3 * WIDTH_A + 2 * WIDTH_B, 3 * WIDTH_A + 3 * WIDTH_B, 3 * WIDTH_A + 3 * WIDTH_B + D_MODEL)
IN_COLS = 3 * WIDTH_A + 3 * WIDTH_B + 2 * D_MODEL

kernel_name = "hybrid_dilated_neighbourhood_encoder"


def _rms_norm(x, g):
    xf = x.astype(jnp.float32)
    y = xf * lax.rsqrt(jnp.mean(xf * xf, axis=-1, keepdims=True) + EPS)
    return (y * g.astype(jnp.float32)).astype(x.dtype)


def _heads(t, n_heads):
    return t.reshape(t.shape[0], t.shape[1], n_heads, HEAD_DIM)


def _partial_rope(x, pos):
    half = ROPE_DIM // 2
    inv = jnp.power(jnp.float32(ROPE_THETA), -jnp.arange(half, dtype=jnp.float32) / half)
    ang = pos.astype(jnp.float32)[:, None] * inv[None, :]
    cos = jnp.cos(ang)[None, :, None, :]
    sin = jnp.sin(ang)[None, :, None, :]
    xr = x[..., :ROPE_DIM].astype(jnp.float32)
    x1, x2 = xr[..., :half], xr[..., half:]
    rot = jnp.concatenate([x1 * cos - x2 * sin, x1 * sin + x2 * cos], axis=-1).astype(x.dtype)
    return jnp.concatenate([rot, x[..., ROPE_DIM:]], axis=-1)


def _banded_window_attention(q, k, v, half):
    n, L, H, dh = q.shape
    blk = half
    nb = -(-L // blk)
    pad = nb * blk - L
    qb = jnp.pad(q, ((0, 0), (0, pad), (0, 0), (0, 0))).reshape(n, nb, blk, H, dh)

    def band(t):
        tb = jnp.pad(t, ((0, 0), (blk, pad + blk), (0, 0), (0, 0))).reshape(n, nb + 2, blk, H, dh)
        return jnp.concatenate([tb[:, :-2], tb[:, 1:-1], tb[:, 2:]], axis=2)

    kw, vw = band(k), band(v)
    s = jnp.einsum("nbqhd,nbkhd->nbhqk", qb, kw, preferred_element_type=jnp.float32) * (HEAD_DIM ** -0.5)
    qi = jnp.arange(nb)[:, None] * blk + jnp.arange(blk)[None, :]
    kj = jnp.arange(nb)[:, None] * blk - blk + jnp.arange(3 * blk)[None, :]
    valid = ((jnp.abs(kj[:, None, :] - qi[:, :, None]) <= half)
             & (kj[:, None, :] >= 0) & (kj[:, None, :] < L))
    s = jnp.where(valid[None, :, None], s, NEG_INF)
    m = jnp.max(s, axis=-1, keepdims=True)
    p = jnp.exp(s - m)
    den = jnp.sum(p, axis=-1, keepdims=True)
    o = jnp.einsum("nbhqk,nbkhd->nbqhd", (p / den).astype(v.dtype), vw)
    lse = (m + jnp.log(den))[..., 0]
    o = o.reshape(n, nb * blk, H, dh)[:, :L]
    lse = lse.transpose(0, 1, 3, 2).reshape(n, nb * blk, H)[:, :L]
    return o, lse


def _dilated_mixture_attention(q, k, v):
    B, S, H, dh = q.shape
    outs, lses = [], []
    for window, dil in DILATED_PATTERNS:
        half = window // (2 * dil)
        L = S // dil

        def to_res(t):
            return t.reshape(B, L, dil, H, dh).transpose(0, 2, 1, 3, 4).reshape(B * dil, L, H, dh)

        o, lse = _banded_window_attention(to_res(q), to_res(k), to_res(v), half)
        outs.append(o.reshape(B, dil, L, H, dh).transpose(0, 2, 1, 3, 4).reshape(B, S, H, dh))
        lses.append(lse.reshape(B, dil, L, H).transpose(0, 2, 1, 3).reshape(B, S, H))
    w = jax.nn.softmax(jnp.stack(lses), axis=0)
    out = jnp.einsum("pbsh,pbshd->bshd", w, jnp.stack(outs).astype(jnp.float32))
    return out.astype(q.dtype)


def _neighbourhood_attention(q, k, v, rpb):
    B, S, H, dh = q.shape
    rows = S // GRID_W
    kh = min(NA_ROWS_MAX, rows)
    ncb = GRID_W // NA_COL_BLOCK
    col_q = jnp.arange(GRID_W).reshape(ncb, NA_COL_BLOCK)
    cs = jnp.clip(col_q - NA_COLS // 2, 0, GRID_W - NA_COLS)
    span0 = jnp.clip(jnp.arange(ncb) * NA_COL_BLOCK - NA_COLS // 2, 0, GRID_W - NA_COL_SPAN)
    col_k = span0[:, None] + jnp.arange(NA_COL_SPAN)[None, :]
    col_ok = (col_k[:, None, :] >= cs[:, :, None]) & (col_k[:, None, :] < cs[:, :, None] + NA_COLS)
    col_rel = jnp.clip(col_k[:, None, :] - col_q[:, :, None] + NA_COLS - 1, 0, RPB_COLS - 1)
    qg = q.reshape(B, rows, ncb, NA_COL_BLOCK, H, dh)
    kg = k.reshape(B, rows, GRID_W, H, dh)[:, :, col_k]
    vg = v.reshape(B, rows, GRID_W, H, dh)[:, :, col_k]
    scale = HEAD_DIM ** -0.5

    def one_row(r):
        rs = jnp.clip(r - kh // 2, 0, rows - kh)
        kr = lax.dynamic_slice_in_dim(kg, rs, kh, axis=1)
        vr = lax.dynamic_slice_in_dim(vg, rs, kh, axis=1)
        qr = lax.dynamic_index_in_dim(qg, r, axis=1, keepdims=False)
        row_rel = rs + jnp.arange(kh) - r + NA_ROWS_MAX - 1
        bias = rpb[:, row_rel[:, None, None, None], col_rel[None]]
        bias = bias.transpose(0, 2, 3, 1, 4).astype(jnp.float32)
        s = jnp.einsum("bnqhd,binkhd->bhnqik", qr, kr, preferred_element_type=jnp.float32) * scale + bias[None]
        s = jnp.where(col_ok[None, None, :, :, None, :], s, NEG_INF)
        p = jax.nn.softmax(s.reshape(B, H, ncb, NA_COL_BLOCK, kh * NA_COL_SPAN), axis=-1)
        p = p.reshape(s.shape).astype(v.dtype)
        return jnp.einsum("bhnqik,binkhd->bnqhd", p, vr)

    out = lax.map(one_row, jnp.arange(rows))
    return jnp.moveaxis(out, 0, 1).reshape(B, S, H, dh)


def _token_mixer(h, w_in, rpb, w_branch_a, w_branch_b, w_out):
    B, S, _ = h.shape
    proj = jnp.einsum("bsd,de->bse", h, w_in)
    qa, ka, va, qb, kb, vb, ga, gb = jnp.split(proj, IN_SPLITS, axis=-1)
    pos = jnp.arange(S)
    qa = _partial_rope(_heads(qa, N_HEADS_A), pos)
    ka = _partial_rope(_heads(ka, N_HEADS_A), pos)
    ya = _dilated_mixture_attention(qa, ka, _heads(va, N_HEADS_A)).reshape(B, S, WIDTH_A)
    yb = _neighbourhood_attention(_heads(qb, N_HEADS_B), _heads(kb, N_HEADS_B),
                                  _heads(vb, N_HEADS_B), rpb).reshape(B, S, WIDTH_B)
    ya = jnp.einsum("bse,ed->bsd", ya, w_branch_a)
    yb = jnp.einsum("bse,ed->bsd", yb, w_branch_b)
    merged = jax.nn.sigmoid(ga) * ya + jax.nn.sigmoid(gb) * yb
    return jnp.einsum("bsd,de->bse", merged, w_out)


def _conv_ffn(h, w_up, conv_w, conv_b, w_down):
    S = h.shape[1]
    u = jnp.einsum("bsd,df->bsf", h, w_up)
    pad = CONV_W // 2
    up = jnp.pad(u, ((0, 0), (pad, pad), (0, 0)))
    u = sum(conv_w[t] * up[:, t:t + S] for t in range(CONV_W)) + conv_b
    val, gate = jnp.split(u, 2, axis=-1)
    return jnp.einsum("bsf,fd->bsd", jax.nn.gelu(gate, approximate=True) * val, w_down)


def _trunk(x, c, w_ada, b_ada, g_mix_pre, g_mix_post, g_ffn_pre, g_ffn_post, w_in, rpb,
           w_branch_a, w_branch_b, w_out, w_up, conv_w, conv_b, w_down):
    for l in range(DEPTH):
        mod = jnp.einsum("bd,de->be", jax.nn.silu(c), w_ada[l]) + b_ada[l]
        sh1, sc1, gt1, sh2, sc2, gt2 = jnp.split(mod[:, None, :], 6, axis=-1)
        h = _rms_norm(x, g_mix_pre[l]) * (1 + sc1) + sh1
        x = x + gt1 * _rms_norm(_token_mixer(h, w_in[l], rpb[l], w_branch_a[l], w_branch_b[l], w_out[l]), g_mix_post[l])
        h = _rms_norm(x, g_ffn_pre[l]) * (1 + sc2) + sh2
        x = x + gt2 * _rms_norm(_conv_ffn(h, w_up[l], conv_w[l], conv_b[l], w_down[l]), g_ffn_post[l])
    return x


def setup_inputs(seed: int = 0) -> dict:
    key = jax.random.key(seed)
    ks = jax.random.split(key, 20)
    D, L = D_MODEL, DEPTH

    def nrm(k, shape, scale):
        return jax.random.normal(k, shape, jnp.float32) * scale

    return {
        "x_prompt": nrm(ks[0], (BATCH, SEQ, D), 1.0),
        "x_sample": nrm(ks[1], (DEC_BATCH, DEC_SEQ, D), 1.0),
        "c_prompt": nrm(ks[2], (BATCH, D), 1.0),
        "c_sample": nrm(ks[3], (DEC_BATCH, D), 1.0),
        "w_ada": nrm(ks[4], (L, D, 6 * D), 0.5 * D ** -0.5),
        "b_ada": nrm(ks[5], (L, 6 * D), 0.02),
        "g_mix_pre": 1.0 + nrm(ks[6], (L, D), 0.05),
        "g_mix_post": 1.0 + nrm(ks[7], (L, D), 0.05),
        "g_ffn_pre": 1.0 + nrm(ks[8], (L, D), 0.05),
        "g_ffn_post": 1.0 + nrm(ks[9], (L, D), 0.05),
        "w_in": nrm(ks[10], (L, D, IN_COLS), D ** -0.5),
        "rpb": nrm(ks[11], (L, N_HEADS_B, RPB_ROWS, RPB_COLS), 0.1),
        "w_branch_a": nrm(ks[12], (L, WIDTH_A, D), WIDTH_A ** -0.5),
        "w_branch_b": nrm(ks[13], (L, WIDTH_B, D), WIDTH_B ** -0.5),
        "w_out": nrm(ks[14], (L, D, D), D ** -0.5),
        "w_up": nrm(ks[15], (L, D, 2 * D_FF), D ** -0.5),
        "conv_w": nrm(ks[16], (L, CONV_W, 2 * D_FF), CONV_W ** -0.5),
        "conv_b": nrm(ks[17], (L, 2 * D_FF), 0.02),
        "w_down": nrm(ks[18], (L, D_FF, D), D_FF ** -0.5),
    }


def reference(x_prompt, x_sample, c_prompt, c_sample, w_ada, b_ada, g_mix_pre, g_mix_post,
              g_ffn_pre, g_ffn_post, w_in, rpb, w_branch_a, w_branch_b, w_out, w_up, conv_w,
              conv_b, w_down):
    y_prompt = _trunk(x_prompt, c_prompt, w_ada, b_ada, g_mix_pre, g_mix_post, g_ffn_pre, g_ffn_post,
                      w_in, rpb, w_branch_a, w_branch_b, w_out, w_up, conv_w, conv_b, w_down)
    y_sample = _trunk(x_sample, c_sample, w_ada, b_ada, g_mix_pre, g_mix_post, g_ffn_pre, g_ffn_post,
                      w_in, rpb, w_branch_a, w_branch_b, w_out, w_up, conv_w, conv_b, w_down)
    return (y_prompt, y_sample)
```

```cpp
#include <hip/hip_runtime.h>
#include <hip/hip_cooperative_groups.h>
#include <cstdio>
#include <cstdint>
namespace cg = cooperative_groups;

#ifndef N_LAUNCH_MODE
#define N_LAUNCH_MODE 1
#endif

constexpr int DM = 1024, SEQ = 2048, NSEQ = 24, NSEQ_P = 8, MTOK = NSEQ * SEQ;
constexpr int NIN = 5120, NQKV = 3072, NGATE = 2048, DFF = 2816, NUP = 2 * DFF;
constexpr int NMOD = 6 * DM;
constexpr float EPS = 1e-6f;
constexpr float LOG2E = 1.4426950408889634f;
constexpr float C2 = 0.125f * LOG2E;
constexpr int NPH = 13;

constexpr size_t MiB = 1u << 20;
constexpr size_t WS_CTL = 0, CTL_ZERO_BYTES = 1 * MiB;
constexpr size_t WS_MOD = 1 * MiB;
constexpr size_t WS_ROPE = 2 * MiB;
constexpr size_t WS_WIN = 4 * MiB;
constexpr size_t WS_WAB = 14 * MiB;
constexpr size_t WS_WOUT = 16 * MiB;
constexpr size_t WS_WUP = 18 * MiB;
constexpr size_t WS_WDN = 29 * MiB;
constexpr size_t WS_H = 36 * MiB;
constexpr size_t WS_QKV = 132 * MiB;
constexpr size_t WS_LSE = 420 * MiB;
constexpr size_t WS_EDGE = 422 * MiB;
constexpr size_t WS_X1 = 512 * MiB;
constexpr size_t WS_END = 608 * MiB;
static_assert(WS_EDGE + (size_t)384 * 2 * 4 * DFF * 4 <= WS_END, "ws map");
static_assert(WS_QKV + (size_t)MTOK * NQKV * 2 <= WS_LSE && WS_QKV + (size_t)MTOK * DFF * 2 <= WS_LSE, "ws map");

constexpr int RING_BYTES = 131072;
constexpr int LDS_BYTES = 163840;
constexpr int MISC_OFF = LDS_BYTES - 256;

#define LAS __attribute__((address_space(3)))
#define GAS __attribute__((address_space(1)))
typedef unsigned short bf16;
typedef unsigned v4u __attribute__((ext_vector_type(4)));
typedef unsigned v2u __attribute__((ext_vector_type(2)));
typedef float f32x4 __attribute__((ext_vector_type(4)));
typedef float f32x2 __attribute__((ext_vector_type(2)));
typedef double f64x2 __attribute__((ext_vector_type(2)));
typedef float f32x16 __attribute__((ext_vector_type(16)));
typedef short bf16x8 __attribute__((ext_vector_type(8)));
typedef short s16x4 __attribute__((ext_vector_type(4)));
typedef __bf16 bf16x2_t __attribute__((ext_vector_type(2)));

__device__ __forceinline__ unsigned pk2(float lo, float hi) { f32x2 v = {lo, hi}; bf16x2_t b = __builtin_convertvector(v, bf16x2_t); return __builtin_bit_cast(unsigned, b); }
__device__ __forceinline__ float bf_lo(unsigned w) { return __uint_as_float(w << 16); }
__device__ __forceinline__ float bf_hi(unsigned w) { return __uint_as_float(w & 0xffff0000u); }
__device__ __forceinline__ float wave_sum(float v) {
#pragma unroll
    for (int o = 1; o < 64; o <<= 1) v += __shfl_xor(v, o);
    return v;
}
__device__ __forceinline__ float fast_exp2(float x) { return __builtin_amdgcn_exp2f(x); }
__device__ __forceinline__ float fast_rcp(float x) { return __builtin_amdgcn_rcpf(x); }
__device__ __forceinline__ float gelu_tanh(float x) {
    const float t = x * (1.0f + 0.044715f * x * x);
    const float e = fast_exp2(t * (-2.0f * 0.7978845608028654f * LOG2E));
    return x * fast_rcp(1.0f + e);
}

namespace pg8 {
#define PG8_LAS __attribute__((address_space(3)))
typedef unsigned short bf16_t;
constexpr int BM = 256, BK = 64, HALF = 128, HTB = HALF * BK * 2, STAGE_BYTES = 8 * HTB, NXCD = 8, WGM = 8;

__host__ __device__ __forceinline__ int lds_byte(int r, int c) { const int st = (r >> 4) * 2 + (c >> 5), rr = r & 15, cc = c & 31, ob = rr * 64 + cc * 2; return st * 1024 + (ob ^ (((ob >> 9) & 1) << 5)); }
__host__ __device__ __forceinline__ void stage_rc(int b, int& R, int& C) { const int st = b / 1024, sb = b % 1024, swz = sb ^ (((sb >> 9) & 1) << 5); R = (st >> 1) * 16 + swz / 64; C = (st & 1) * 32 + (swz % 64) / 2; }
__host__ __device__ __forceinline__ int perm32(int rho) { const int n = rho >> 4, i = rho & 15; return 8 * (i >> 2) + 4 * n + (i & 3); }

struct Unit { int pm, pn; };
struct Gemm { const bf16_t* A; const bf16_t* Bt; int nM, nN, K; size_t b_tile, b_half; };

struct StaticOrder {
    int nM, nN, nwg, G, c;
    __host__ __device__ void init(int nM_, int nN_, int G_, int c_) { nM = nM_; nN = nN_; nwg = nM * nN; G = G_; c = c_; }
    __host__ __device__ bool next(int i, Unit& u) const {
        const long L = (long)i * G + c; if (L >= nwg) return false;
        int wgid = (int)L; { const int q = nwg / NXCD, r = nwg % NXCD, xcd = wgid % NXCD, off = wgid / NXCD; wgid = (xcd < r ? xcd * (q + 1) : r * (q + 1) + (xcd - r) * q) + off; }
        const int nig = WGM * nN, gid = wgid / nig, fm = gid * WGM, gsz = (nM - fm) < WGM ? (nM - fm) : WGM;
        u.pm = fm + ((wgid % nig) % gsz); u.pn = (wgid % nig) / gsz; return true;
    }
};


template <class Epi, bool ALIGN_EPI, bool AREMAP>
__device__ __forceinline__ void gemm_phase(PG8_LAS unsigned char* lds, const Gemm g, const StaticOrder& S, const Epi& E) {
    const int tid = threadIdx.x, wid = __builtin_amdgcn_readfirstlane(tid >> 6), lane = tid & 63, wr = wid >> 2, wc = wid & 3, fr = lane & 15, fq = lane >> 4;
    const int K = g.K, nt = K / BK;
    unsigned voffA[2], voffB[2];
#pragma unroll
    for (int i = 0; i < 2; ++i) { int R, C; stage_rc(tid * 16 + i * 8192, R, C); const int Rb = Epi::PERM ? ((R & ~31) + perm32(R & 31)) : R;
        const int Ra = AREMAP ? (128 * (R >> 6) + 8 * (R & 15) + ((R >> 4) & 3)) : R;
        voffA[i] = (unsigned)(Ra * K + C) * 2u; voffB[i] = (unsigned)(Rb * K + C) * 2u; }
    const size_t kstep = (size_t)(BK * 2);
    const size_t hstepA = AREMAP ? (size_t)4 * K * 2 : (size_t)HALF * K * 2;
    const size_t tstepA = (size_t)BM * K * 2;
    const size_t hstepB = g.b_half, tstepB = g.b_tile;
    const unsigned ldsw = (unsigned)wid * 1024u;
    const int aoff = lds_byte(wr * 64 + fr, fq * 8), boff = lds_byte(wc * 32 + fr, fq * 8);
#define PG8_SA(b, h) (((b) * 2 + (h)) * HTB)
#define PG8_SB(b, h) ((4 + (b) * 2 + (h)) * HTB)
#define PG8_STAGE(bufoff, gbase, voff) do { _Pragma("unroll") for (int _i = 0; _i < 2; ++_i) \
        __builtin_amdgcn_global_load_lds((const unsigned*)((const char*)(gbase) + (voff)[_i]), (PG8_LAS unsigned*)(lds + (bufoff) + ldsw + _i * 8192), 16, 0, 0); } while (0)
#define PG8_LDA(dst, b, h) do { _Pragma("unroll") for (int m = 0; m < 4; ++m) _Pragma("unroll") for (int k = 0; k < 2; ++k) dst[m][k] = *(const PG8_LAS bf16x8*)(lds + PG8_SA(b, h) + aoff + m * 2048 + k * 1024); } while (0)
#define PG8_LDB(dst, b, h) do { _Pragma("unroll") for (int n = 0; n < 2; ++n) _Pragma("unroll") for (int k = 0; k < 2; ++k) dst[n][k] = *(const PG8_LAS bf16x8*)(lds + PG8_SB(b, h) + boff + n * 2048 + k * 1024); } while (0)
#define PG8_MMA(ai, bj, At, Bt) do { __builtin_amdgcn_s_setprio(1); _Pragma("unroll") for (int m = 0; m < 4; ++m) _Pragma("unroll") for (int n = 0; n < 2; ++n) _Pragma("unroll") for (int k = 0; k < 2; ++k) \
        acc[ai][bj][m][n] = __builtin_amdgcn_mfma_f32_16x16x32_bf16(Bt[n][k], At[m][k], acc[ai][bj][m][n], 0, 0, 0); __builtin_amdgcn_s_setprio(0); } while (0)
#define PG8_WAIT_V(n) asm volatile("s_waitcnt vmcnt(" #n ")" ::: "memory")
#define PG8_WAIT_L(n) asm volatile("s_waitcnt lgkmcnt(" #n ")" ::: "memory")
#define PG8_BAR __builtin_amdgcn_s_barrier()
#define PG8_SCHED __builtin_amdgcn_sched_barrier(0)
    Unit cur, nxt; int ui = 0;
    if (!S.next(0, cur)) return;
    f32x4 acc[2][2][4][2];
#pragma unroll
    for (int a = 0; a < 2; ++a)
#pragma unroll
        for (int b = 0; b < 2; ++b)
#pragma unroll
            for (int m = 0; m < 4; ++m)
#pragma unroll
                for (int n = 0; n < 2; ++n) acc[a][b][m][n] = (f32x4){0.f, 0.f, 0.f, 0.f};
    bf16x8 At[4][2], B0[2][2], B1[2][2];
    int pf_t = 2; asm volatile("" : "+s"(pf_t));
    const char* cA = (const char*)g.A + (size_t)cur.pm * tstepA; const char* cB = (const char*)g.Bt + (size_t)cur.pn * tstepB;
    PG8_STAGE(PG8_SB(0, 0), cB, voffB); PG8_STAGE(PG8_SB(0, 1), cB + hstepB, voffB); PG8_STAGE(PG8_SA(0, 0), cA, voffA); PG8_STAGE(PG8_SA(0, 1), cA + hstepA, voffA);
    if (wr == 1) PG8_BAR;
    PG8_WAIT_V(2); PG8_BAR;
    PG8_STAGE(PG8_SB(1, 0), cB + kstep, voffB); PG8_STAGE(PG8_SA(1, 0), cA + kstep, voffA); PG8_STAGE(PG8_SB(1, 1), cB + hstepB + kstep, voffB);
    PG8_WAIT_V(6); PG8_BAR;
    for (;;) {
        const bool has_next = S.next(ui + 1, nxt);
        const char* nA = has_next ? (const char*)g.A + (size_t)nxt.pm * tstepA : cA; const char* nB = has_next ? (const char*)g.Bt + (size_t)nxt.pn * tstepB : cB;
        for (int t = 0; t < nt; t += 2) {
            const bool last = (t == nt - 2);
            const char* a1 = cA + (size_t)(t + 1) * kstep;
            const char* a2 = last ? nA : cA + (size_t)(t + 2) * kstep; const char* b2 = last ? nB : cB + (size_t)(t + 2) * kstep;
            const char* a3 = a2 + kstep; const char* b3 = b2 + kstep;
            if constexpr (Epi::MIDK) { if (t == (nt >> 1)) E.midk(acc, cur, wr, wc, fr, fq); }
            if constexpr (Epi::PREF) { if (t == pf_t) E.pf_dma(cur, wid, lane); }
            PG8_LDB(B0, 0, 0); PG8_LDB(B1, 0, 1); PG8_SCHED; PG8_LDA(At, 0, 0); PG8_STAGE(PG8_SA(1, 1), a1 + hstepA, voffA);
            PG8_WAIT_V(8); PG8_WAIT_L(0); PG8_BAR; PG8_MMA(0, 0, At, B0); PG8_MMA(0, 1, At, B1); PG8_BAR; PG8_SCHED;
            PG8_LDA(At, 0, 1); PG8_STAGE(PG8_SB(0, 0), b2, voffB); PG8_STAGE(PG8_SB(0, 1), b2 + hstepB, voffB); PG8_STAGE(PG8_SA(0, 0), a2, voffA);
            PG8_WAIT_V(8); PG8_WAIT_L(0); PG8_BAR; PG8_MMA(1, 0, At, B0); PG8_MMA(1, 1, At, B1); PG8_BAR; PG8_SCHED;
            PG8_LDB(B0, 1, 0); PG8_LDB(B1, 1, 1); PG8_SCHED; PG8_LDA(At, 1, 0); PG8_STAGE(PG8_SA(0, 1), a2 + hstepA, voffA);
            PG8_WAIT_V(8); PG8_WAIT_L(0); PG8_BAR; PG8_MMA(0, 0, At, B0); PG8_MMA(0, 1, At, B1); PG8_BAR; PG8_SCHED;
            PG8_LDA(At, 1, 1); PG8_STAGE(PG8_SB(1, 0), b3, voffB); PG8_STAGE(PG8_SB(1, 1), b3 + hstepB, voffB); PG8_STAGE(PG8_SA(1, 0), a3, voffA);
            PG8_WAIT_V(8); PG8_WAIT_L(0); PG8_BAR; PG8_MMA(1, 0, At, B0); PG8_MMA(1, 1, At, B1); PG8_BAR; PG8_SCHED;
        }
        if constexpr (ALIGN_EPI) { if (wr == 0) PG8_BAR; }
        E(acc, cur, wr, wc, fr, fq);
        if (!has_next) break;
#pragma unroll
        for (int a = 0; a < 2; ++a)
#pragma unroll
            for (int b = 0; b < 2; ++b)
#pragma unroll
                for (int m = 0; m < 4; ++m)
#pragma unroll
                    for (int n = 0; n < 2; ++n) { double z0, z1; asm volatile("v_mov_b64 %0, 0" : "=v"(z0)); asm volatile("v_mov_b64 %0, 0" : "=v"(z1));
                        const f64x2 z = {z0, z1}; acc[a][b][m][n] = __builtin_bit_cast(f32x4, z); }
        cur = nxt; cA = nA; cB = nB; ++ui;
        if constexpr (ALIGN_EPI) { if (wr == 1) PG8_BAR; }
    }
    PG8_WAIT_V(0);
    if constexpr (!ALIGN_EPI) { if (wr == 0) PG8_BAR; }
    PG8_BAR;
#undef PG8_SA
#undef PG8_SB
#undef PG8_STAGE
#undef PG8_LDA
#undef PG8_LDB
#undef PG8_MMA
#undef PG8_WAIT_V
#undef PG8_WAIT_L
#undef PG8_BAR
#undef PG8_SCHED
}

struct EpiBf16 {
    static constexpr bool PERM = true, MIDK = false, PREF = false;
    bf16_t* O; int ldc;
    __device__ __forceinline__ void operator()(const f32x4 (&acc)[2][2][4][2], const Unit& u, int wr, int wc, int fr, int fq) const {
        const int row0 = u.pm * BM + wr * 64 + fr, col0 = u.pn * BM + wc * 32 + 8 * fq;
#pragma unroll
        for (int ai = 0; ai < 2; ++ai)
#pragma unroll
            for (int m = 0; m < 4; ++m) { bf16_t* rowp = O + (size_t)(row0 + ai * HALF + m * 16) * ldc + col0;
#pragma unroll
                for (int bj = 0; bj < 2; ++bj) { const f32x4 v0 = acc[ai][bj][m][0], v1 = acc[ai][bj][m][1];
                    v4u w; w.x = pk2(v0[0], v0[1]); w.y = pk2(v0[2], v0[3]); w.z = pk2(v1[0], v1[1]); w.w = pk2(v1[2], v1[3]);
                    *(v4u*)(rowp + bj * HALF) = w; } }
    }
};

struct EpiQKV {
    static constexpr bool PERM = true, MIDK = false, PREF = false;
    bf16_t* QKV; bf16_t* G; const float* rope;
    static __device__ __forceinline__ unsigned qkv_row_elem(int T, int row, int h) {
        const int b = row >> 11, t = row & (SEQ - 1);
        const int pos = (T < 3) ? ((t & 3) * 512 + ((t >> 2) & 3) * 128 + (t >> 4)) : t;
        return (unsigned)(((T * NSEQ + b) * 8 + h) * SEQ + pos) * 64u;
    }
    __device__ __forceinline__ void operator()(const f32x4 (&acc)[2][2][4][2], const Unit& u, int wr, int wc, int fr, int fq) const {
        const int pn = u.pn;
        const float sc = (pn < 2 || pn == 6 || pn == 7) ? C2 : 1.0f;
        const int row0 = u.pm * BM + wr * 64 + fr;
        if (pn >= 12) {
            const int j_ = pn - 12, pnq = j_ >> 1, bjm = j_ & 1;
            const int hx = ((u.pm * 4 + pnq) * 37) & 127;
            bf16_t* blkR = G + ((size_t)((0 * (MTOK / 256) + u.pm) * 4 + pnq) * 65536) + (fq * 16 + fr) * 8; bf16_t* blkS = blkR + (size_t)(MTOK / 256) * 4 * 65536; const int cw = (wr * 4 + wc) * 16;
#pragma unroll
            for (int ai = 0; ai < 2; ++ai)
#pragma unroll
                for (int m = 0; m < 4; ++m) { float rr[8], ss[8];
#pragma unroll
                    for (int q = 0; q < 8; ++q) { const float ga = fminf(fmaxf(acc[ai][0][m][q >> 2][q & 3], -30.f), 30.f), gb = fminf(fmaxf(acc[ai][1][m][q >> 2][q & 3], -30.f), 30.f);
                        const float ea = fast_exp2(-LOG2E * ga), eb = fast_exp2(-LOG2E * gb); ss[q] = fast_rcp(1.f + eb); rr[q] = (1.f + eb) * fast_rcp(1.f + ea); }
                    v4u wR, wS; wR.x = pk2(rr[0], rr[1]); wR.y = pk2(rr[2], rr[3]); wR.z = pk2(rr[4], rr[5]); wR.w = pk2(rr[6], rr[7]);
                    wS.x = pk2(ss[0], ss[1]); wS.y = pk2(ss[2], ss[3]); wS.z = pk2(ss[4], ss[5]); wS.w = pk2(ss[6], ss[7]);
                    const int off = ((cw + (ai * 4 + m) * 2 + bjm) ^ hx) * 512;
                    *(v4u*)(blkR + off) = wR; *(v4u*)(blkS + off) = wS; }
        } else if (pn < 4) {
            const int T = pn >> 1, hbase = 4 * (pn & 1) + (wc >> 1), coff = 32 * (wc & 1) + 8 * fq;
            const bool rl = ((wc & 1) == 0) && (fq < 2);
            const int fqc = rl ? fq : 0;
#pragma unroll
            for (int ai = 0; ai < 2; ++ai)
#pragma unroll
                for (int m = 0; m < 4; ++m) {
                    const int row = row0 + ai * HALF + m * 16; const int pos = row & (SEQ - 1);
                    const f32x4* rp = (const f32x4*)(rope + (size_t)(pos * 8 + 4 * fqc) * 2);
                    f32x4 cs0 = rp[0], cs1 = rp[1];
                    const f32x4 ident = (f32x4){1.f, 0.f, 1.f, 0.f};
                    cs0 = rl ? cs0 : ident; cs1 = rl ? cs1 : ident;
#pragma unroll
                    for (int bj = 0; bj < 2; ++bj) {
                        bf16_t* dst = QKV + qkv_row_elem(T, row, hbase + 2 * bj) + coff;
                        const f32x4 x1 = acc[ai][bj][m][0] * sc, x2 = acc[ai][bj][m][1] * sc;
                        const float c0 = cs0[0], s0 = cs0[1], c1 = cs0[2], s1 = cs0[3], c2 = cs1[0], s2 = cs1[1], c3 = cs1[2], s3 = cs1[3];
                        unsigned ax = pk2(x1[0] * c0 - x2[0] * s0, x1[1] * c1 - x2[1] * s1), ay = pk2(x1[2] * c2 - x2[2] * s2, x1[3] * c3 - x2[3] * s3);
                        unsigned bx = pk2(x1[0] * s0 + x2[0] * c0, x1[1] * s1 + x2[1] * c1), by = pk2(x1[2] * s2 + x2[2] * c2, x1[3] * s3 + x2[3] * c3);
                        const auto rx = __builtin_amdgcn_permlane16_swap(ax, bx, false, false); const auto ry = __builtin_amdgcn_permlane16_swap(ay, by, false, false);
                        v4u w; w.x = rx[0]; w.y = ry[0]; w.z = rx[1]; w.w = ry[1];
                        *(v4u*)dst = w;
                    }
                }
        } else {
            const int T = pn >> 1, hbase = 4 * (pn & 1) + (wc >> 1), coff = 32 * (wc & 1) + 8 * fq;
#pragma unroll
            for (int ai = 0; ai < 2; ++ai)
#pragma unroll
                for (int m = 0; m < 4; ++m) {
                    const int row = row0 + ai * HALF + m * 16;
#pragma unroll
                    for (int bj = 0; bj < 2; ++bj) {
                        bf16_t* dst = QKV + qkv_row_elem(T, row, hbase + 2 * bj) + coff;
                        const f32x4 x1 = acc[ai][bj][m][0] * sc, x2 = acc[ai][bj][m][1] * sc;
                        v4u w; w.x = pk2(x1[0], x1[1]); w.y = pk2(x1[2], x1[3]); w.z = pk2(x2[0], x2[1]); w.w = pk2(x2[2], x2[3]);
                        *(v4u*)dst = w;
                    }
                }
        }
    }
};

struct EpiMerged {
    static constexpr bool PERM = true, MIDK = true, PREF = false;
    const bf16_t* G; bf16_t* O;
    static __device__ __forceinline__ float eneg(float g) { g = fminf(fmaxf(g, -30.f), 30.f); return fast_exp2(-LOG2E * g); }
    __device__ __forceinline__ void midk(f32x4 (&acc)[2][2][4][2], const Unit& u, int wr, int wc, int fr, int fq) const {
        int fr_ = fr, fq_ = fq; asm volatile("" : "+v"(fr_), "+v"(fq_));
        const int hx = ((u.pm * 4 + u.pn) * 37) & 127, cw = (wr * 4 + wc) * 16;
        const bf16_t* ba = G + ((size_t)((0 * (MTOK / 256) + u.pm) * 4 + u.pn) * 65536) + (fq_ * 16 + fr_) * 8;
        v4u rr[8][2];
#pragma unroll
        for (int g = 0; g < 8; ++g) { rr[g][0] = *(const v4u*)(ba + ((cw + g * 2 + 0) ^ hx) * 512); rr[g][1] = *(const v4u*)(ba + ((cw + g * 2 + 1) ^ hx) * 512); }
        asm volatile("" ::: "memory");
#pragma unroll
        for (int g = 0; g < 8; ++g)
#pragma unroll
            for (int bj = 0; bj < 2; ++bj)
#pragma unroll
                for (int q = 0; q < 4; ++q) { acc[g >> 2][bj][g & 3][q >> 1][(q & 1) * 2] *= bf_lo(rr[g][bj][q]); acc[g >> 2][bj][g & 3][q >> 1][(q & 1) * 2 + 1] *= bf_hi(rr[g][bj][q]); }
    }
    __device__ __forceinline__ void operator()(const f32x4 (&acc)[2][2][4][2], const Unit& u, int wr, int wc, int fr, int fq) const {
        int fr_ = fr, fq_ = fq; asm volatile("" : "+v"(fr_), "+v"(fq_));
        const int row0 = u.pm * BM + wr * 64 + fr_, col0 = u.pn * BM + wc * 32 + 8 * fq_;
        const int hx = ((u.pm * 4 + u.pn) * 37) & 127, cw = (wr * 4 + wc) * 16;
        const bf16_t* bb = G + ((size_t)((1 * (MTOK / 256) + u.pm) * 4 + u.pn) * 65536) + (fq_ * 16 + fr_) * 8;
        v4u sa[2], sb[2];
#define LDG(dst, g_) do { dst[0] = *(const v4u*)(bb + ((cw + (g_) * 2 + 0) ^ hx) * 512); dst[1] = *(const v4u*)(bb + ((cw + (g_) * 2 + 1) ^ hx) * 512); } while (0)
#define USE(src, g_) do { const size_t row = (size_t)(row0 + ((g_) >> 2) * HALF + ((g_) & 3) * 16); _Pragma("unroll") for (int bj = 0; bj < 2; ++bj) { float o[8]; \
            _Pragma("unroll") for (int q = 0; q < 4; ++q) { o[2 * q] = acc[(g_) >> 2][bj][(g_) & 3][q >> 1][(q & 1) * 2] * bf_lo(src[bj][q]); o[2 * q + 1] = acc[(g_) >> 2][bj][(g_) & 3][q >> 1][(q & 1) * 2 + 1] * bf_hi(src[bj][q]); } \
            v4u w; w.x = pk2(o[0], o[1]); w.y = pk2(o[2], o[3]); w.z = pk2(o[4], o[5]); w.w = pk2(o[6], o[7]); *(v4u*)(O + row * DM + col0 + bj * HALF) = w; } } while (0)
        LDG(sa, 0);
#pragma unroll
        for (int g = 0; g < 8; g += 2) {
            LDG(sb, g + 1); asm volatile("" ::: "memory"); USE(sa, g);
            if (g + 2 < 8) LDG(sa, g + 2); asm volatile("" ::: "memory"); USE(sb, g + 1);
        }
#undef LDG
#undef USE
    }
};

struct EpiUp {
    static constexpr bool PERM = true, MIDK = false, PREF = true;
    bf16_t* Gout; float* edge; const float* cw; const float* cb; PG8_LAS float* cl;
    static __device__ __forceinline__ float dpp_prev(float v) { return __int_as_float(__builtin_amdgcn_update_dpp(0, __float_as_int(v), 0x111, 0xf, 0xf, true)); }
    static __device__ __forceinline__ float dpp_next(float v) { return __int_as_float(__builtin_amdgcn_update_dpp(0, __float_as_int(v), 0x101, 0xf, 0xf, true)); }
    __device__ __forceinline__ void pf_dma(const Unit& u, int wid, int lane) const {
        if (wid < 4) { int l_ = lane; asm volatile("" : "+v"(l_));
            const int t_ = wid * 64 + l_, kind = t_ >> 5, c4 = t_ & 31; const float* base = ((kind & 3) == 3) ? cb : cw + (kind & 3) * NUP;
            __builtin_amdgcn_global_load_lds((const unsigned*)(base + (kind >> 2) * DFF + u.pn * 128 + 4 * c4), (PG8_LAS unsigned*)(cl + wid * 256), 16, 0, 0); }
    }
    static __device__ __forceinline__ f32x4 dpp_prev4(f32x4 v) { return (f32x4){dpp_prev(v[0]), dpp_prev(v[1]), dpp_prev(v[2]), dpp_prev(v[3])}; }
    static __device__ __forceinline__ f32x4 dpp_next4(f32x4 v) { return (f32x4){dpp_next(v[0]), dpp_next(v[1]), dpp_next(v[2]), dpp_next(v[3])}; }
    __device__ __forceinline__ void operator()(const f32x4 (&acc)[2][2][4][2], const Unit& u, int wr, int wc, int fr, int fq) const {
        const int f0 = u.pn * 128 + wc * 32 + 8 * fq;
        const int tok0 = u.pm * BM + wr * 128 + 8 * fr;
        const int blk = u.pm * 2 + wr;
        float* e0p = edge + (size_t)(blk * 2 + 0) * 4 * DFF + f0;
        float* e7p = edge + (size_t)(blk * 2 + 1) * 4 * DFF + f0;
        const PG8_LAS float* cl0 = cl + wc * 32 + 8 * fq;
        constexpr float GK = -2.0f * 0.7978845608028654f * LOG2E;
        unsigned res[8][2];
#pragma unroll
        for (int n = 0; n < 2; ++n) {
            const f32x4 w0v = *(const PG8_LAS f32x4*)(cl0 + 0 * 128 + 4 * n), w1v = *(const PG8_LAS f32x4*)(cl0 + 1 * 128 + 4 * n), w2v = *(const PG8_LAS f32x4*)(cl0 + 2 * 128 + 4 * n), bv = *(const PG8_LAS f32x4*)(cl0 + 3 * 128 + 4 * n);
            const f32x4 w0g = *(const PG8_LAS f32x4*)(cl0 + 4 * 128 + 4 * n), w1g = *(const PG8_LAS f32x4*)(cl0 + 5 * 128 + 4 * n), w2g = *(const PG8_LAS f32x4*)(cl0 + 6 * 128 + 4 * n), bg = *(const PG8_LAS f32x4*)(cl0 + 7 * 128 + 4 * n);
#define UP_V(g_) acc[(g_) >> 2][0][(g_) & 3][n]
#define UP_G(g_) acc[(g_) >> 2][1][(g_) & 3][n]
            const f32x4 pv = dpp_prev4(UP_V(7)), nv = dpp_next4(UP_V(0)), pg = dpp_prev4(UP_G(7)), ng = dpp_next4(UP_G(0));
#pragma unroll
            for (int g = 0; g < 8; ++g) {
                const f32x4 upv = (g == 0) ? pv : UP_V(g == 0 ? 0 : g - 1), unv = (g == 7) ? nv : UP_V(g == 7 ? 7 : g + 1);
                const f32x4 upg = (g == 0) ? pg : UP_G(g == 0 ? 0 : g - 1), ung = (g == 7) ? ng : UP_G(g == 7 ? 7 : g + 1);
                f32x4 cv = w1v * UP_V(g) + bv; cv = w0v * upv + cv; cv = w2v * unv + cv;
                f32x4 cg = w1g * UP_G(g) + bg; cg = w0g * upg + cg; cg = w2g * ung + cg;
                const f32x4 x2 = cg * cg; const f32x4 p = x2 * (0.044715f * GK) + GK; const f32x4 ar = cg * p;
                const f32x4 d = (f32x4){fast_exp2(ar[0]), fast_exp2(ar[1]), fast_exp2(ar[2]), fast_exp2(ar[3])} + 1.0f;
                const f32x4 r = (f32x4){fast_rcp(d[0]), fast_rcp(d[1]), fast_rcp(d[2]), fast_rcp(d[3])};
                const f32x4 o = (cg * r) * cv;
                if (n == 0) { res[g][0] = pk2(o[0], o[1]); res[g][1] = pk2(o[2], o[3]); }
                else { v4u w; w.x = res[g][0]; w.y = res[g][1]; w.z = pk2(o[0], o[1]); w.w = pk2(o[2], o[3]); *(v4u*)(Gout + (size_t)(tok0 + g) * DFF + f0) = w; }
                if (g == 0) { if (fr == 0) { *(f32x4*)(e0p + 4 * n) = cv; *(f32x4*)(e0p + DFF + 4 * n) = cg; *(f32x4*)(e0p + 2 * DFF + 4 * n) = UP_V(0); *(f32x4*)(e0p + 3 * DFF + 4 * n) = UP_G(0); } }
                if (g == 7) { if (fr == 15) { *(f32x4*)(e7p + 4 * n) = cv; *(f32x4*)(e7p + DFF + 4 * n) = cg; *(f32x4*)(e7p + 2 * DFF + 4 * n) = UP_V(7); *(f32x4*)(e7p + 3 * DFF + 4 * n) = UP_G(7); } }
            }
#undef UP_V
#undef UP_G
        }
    }
};
}

struct Frame {
    LAS unsigned char* lds;
    int tid, lane, wave, vcu, G;
    const float* xp; const float* xs; const float* cp; const float* cs;
    const float *w_ada, *b_ada, *g_mix_pre, *g_mix_post, *g_ffn_pre, *g_ffn_post, *w_in, *rpb, *w_a, *w_b, *w_out, *w_up, *conv_w, *conv_b, *w_down;
    float* out; unsigned char* ws;
    float* mod; float* rope; float* lse; float* edge;
    bf16 *Win_t, *Wab_t, *Wout_t, *Wup_t, *Wdn_t, *H, *QKV, *GATE;
};
__device__ __forceinline__ const float* x_row(const Frame& F, int m) { return (m < NSEQ_P * SEQ) ? F.xp + (size_t)m * DM : F.xs + (size_t)(m - NSEQ_P * SEQ) * DM; }

template <bool ROPEPERM>
__device__ __forceinline__ void p0_transpose_item(const float* W, int K, int N, bf16* WT, int ldk, int koff, LAS float* scr, int item, int lane) {
    const int nblk = N / 32, kb = item / nblk, nb = item % nblk, k0 = 64 * kb, n0 = 32 * nb;
    float wv[32];
#pragma unroll
    for (int i = 0; i < 32; ++i) wv[i] = W[(size_t)(k0 + 2 * i + (lane >> 5)) * N + n0 + (lane & 31)];
#pragma unroll
    for (int i = 0; i < 32; ++i) scr[(2 * i + (lane >> 5)) * 33 + (lane & 31)] = wv[i];
    asm volatile("s_waitcnt lgkmcnt(0)" ::: "memory");
    const int c = lane & 7;
#pragma unroll
    for (int j = 0; j < 4; ++j) { const int n = (lane >> 3) + 8 * j; const LAS float* s = scr + (8 * c) * 33 + n;
        v4u o; o.x = pk2(s[0 * 33], s[1 * 33]); o.y = pk2(s[2 * 33], s[3 * 33]); o.z = pk2(s[4 * 33], s[5 * 33]); o.w = pk2(s[6 * 33], s[7 * 33]);
        int dn = n0 + n;
        if (ROPEPERM) { if (dn < 1024) dn = (dn & ~12) | ((dn & 4) << 1) | ((dn & 8) >> 1);
                        else if (dn >= NQKV) { const int g_ = dn - NQKV, ty = g_ >> 10, c_ = g_ & 1023; dn = NQKV + (c_ >> 7) * 256 + ty * 128 + (c_ & 127); } }
        *(v4u*)(WT + (size_t)dn * ldk + koff + k0 + 8 * c) = o; }
    asm volatile("s_waitcnt lgkmcnt(0)" ::: "memory");
}

__device__ __forceinline__ void p0_mod_item(Frame& F, int item) {
    LAS float* sc = (LAS float*)(F.lds) + F.wave * 3072;
    const int k0 = 128 * F.wave, e0 = 32 * item, hh = F.lane >> 5, col = F.lane & 31;
#pragma unroll
    for (int b16 = 0; b16 < 3; ++b16) { float cv[16];
#pragma unroll
        for (int i = 0; i < 16; ++i) { const int idx = F.lane + 64 * (16 * b16 + i), s = idx >> 7, kk = idx & 127;
            cv[i] = (s < NSEQ_P) ? F.cp[s * DM + k0 + kk] : F.cs[(s - NSEQ_P) * DM + k0 + kk]; }
#pragma unroll
        for (int i = 0; i < 16; ++i) { const int idx = F.lane + 64 * (16 * b16 + i); sc[idx] = cv[i] / (1.0f + __expf(-cv[i])); } }
    float acc[24];
#pragma unroll
    for (int s = 0; s < 24; ++s) acc[s] = 0.f;
    const float* wp = F.w_ada + (size_t)(k0 + 64 * hh) * NMOD + e0 + col;
#pragma unroll
    for (int c16 = 0; c16 < 4; ++c16) {
        float w[16];
#pragma unroll
        for (int i = 0; i < 16; ++i) w[i] = wp[(size_t)(16 * c16 + i) * NMOD];
        asm volatile("s_waitcnt lgkmcnt(0)" ::: "memory");
#pragma unroll
        for (int k4 = 0; k4 < 4; ++k4) {
#pragma unroll
            for (int s = 0; s < 24; ++s) { const f32x4 v = *(const LAS f32x4*)(sc + s * 128 + 64 * hh + 16 * c16 + 4 * k4);
                acc[s] += v[0] * w[4 * k4] + v[1] * w[4 * k4 + 1] + v[2] * w[4 * k4 + 2] + v[3] * w[4 * k4 + 3]; }
        }
    }
    asm volatile("s_waitcnt lgkmcnt(0)" ::: "memory");
#pragma unroll
    for (int s = 0; s < 24; ++s) sc[s * 64 + F.lane] = acc[s];
    __syncthreads();
    for (int o = F.tid; o < 24 * 32; o += 512) { const int s = o >> 5, c = o & 31; float v = F.b_ada[e0 + c];
#pragma unroll
        for (int w = 0; w < 8; ++w) v += ((LAS float*)F.lds)[w * 3072 + s * 64 + c] + ((LAS float*)F.lds)[w * 3072 + s * 64 + 32 + c];
        F.mod[s * NMOD + e0 + c] = v; }
    __syncthreads();
}

__device__ __forceinline__ void phase_prologue(Frame& F) {
    const int gw = F.vcu * 8 + F.wave, NGW = F.G * 8;
    if (F.G >= 192 && F.vcu >= F.G - 192) p0_mod_item(F, F.vcu - (F.G - 192));
    else if (F.G < 192) { for (int it = F.vcu; it < 192; it += F.G) p0_mod_item(F, it); }
    for (int e = gw * 64 + F.lane; e < SEQ * 8; e += NGW * 64) { const int pos = e >> 3, i = e & 7;
        const float inv = powf(500000.0f, -(float)i / 8.0f); const float ang = (float)pos * inv;
        F.rope[2 * e] = cosf(ang); F.rope[2 * e + 1] = sinf(ang); }
    LAS float* scr = (LAS float*)(F.lds) + F.wave * 4096;
    constexpr int I_IN = (DM / 64) * (NIN / 32), I_A = (512 / 64) * (DM / 32), I_O = (DM / 64) * (DM / 32), I_UP = (DM / 64) * (NUP / 32), I_DN = (DFF / 64) * (DM / 32);
    constexpr int NITEMS = I_IN + 2 * I_A + I_O + I_UP + I_DN;
    for (int it = gw; it < NITEMS; it += NGW) {
        int r = it;
        if (r < I_IN) { p0_transpose_item<true>(F.w_in, DM, NIN, F.Win_t, DM, 0, scr, r, F.lane); continue; } r -= I_IN;
        if (r < I_A) { p0_transpose_item<false>(F.w_a, 512, DM, F.Wab_t, DM, 0, scr, r, F.lane); continue; } r -= I_A;
        if (r < I_A) { p0_transpose_item<false>(F.w_b, 512, DM, F.Wab_t, DM, 512, scr, r, F.lane); continue; } r -= I_A;
        if (r < I_O) { p0_transpose_item<false>(F.w_out, DM, DM, F.Wout_t, DM, 0, scr, r, F.lane); continue; } r -= I_O;
        if (r < I_UP) { p0_transpose_item<false>(F.w_up, DM, NUP, F.Wup_t, DM, 0, scr, r, F.lane); continue; } r -= I_UP;
        p0_transpose_item<false>(F.w_down, DFF, DM, F.Wdn_t, DFF, 0, scr, r, F.lane);
    }
}

constexpr int ROWS_PER_CHUNK = 24;
__device__ __forceinline__ float sumsq4(const f32x4 (&v)[4]) { float s = 0.f;
#pragma unroll
    for (int j = 0; j < 4; ++j) s += (v[j].x * v[j].x + v[j].y * v[j].y) + (v[j].z * v[j].z + v[j].w * v[j].w);
    return s; }
__device__ __forceinline__ void ld_f32row(f32x4 (&v)[4], const float* row, int lane) { const f32x4* p = (const f32x4*)row + lane;
#pragma unroll
    for (int j = 0; j < 4; ++j) v[j] = p[64 * j]; }
__device__ __forceinline__ void ld_bf16row(v2u (&v)[4], const bf16* row, int lane) { const v2u* p = (const v2u*)row + lane;
#pragma unroll
    for (int j = 0; j < 4; ++j) v[j] = p[64 * j]; }
__device__ __forceinline__ void cvt_bf16row(f32x4 (&o)[4], const v2u (&v)[4]) {
#pragma unroll
    for (int j = 0; j < 4; ++j) o[j] = (f32x4){bf_lo(v[j].x), bf_hi(v[j].x), bf_lo(v[j].y), bf_hi(v[j].y)}; }
__device__ __forceinline__ void st_bf16row(bf16* row, const f32x4 (&o)[4], int lane) { unsigned long long* p = (unsigned long long*)row + lane;
#pragma unroll
    for (int j = 0; j < 4; ++j) p[64 * j] = (unsigned long long)pk2(o[j].x, o[j].y) | ((unsigned long long)pk2(o[j].z, o[j].w) << 32); }
__device__ __forceinline__ void st_f32row(float* row, const f32x4 (&o)[4], int lane) { f32x4* p = (f32x4*)row + lane;
#pragma unroll
    for (int j = 0; j < 4; ++j) p[64 * j] = o[j]; }

__device__ __forceinline__ void phase_h(Frame& F) {
    const int gw = F.vcu * 8 + F.wave, NGW = F.G * 8;
    for (int ch = gw; ch < MTOK / ROWS_PER_CHUNK; ch += NGW) {
        const int m0 = ch * ROWS_PER_CHUNK; int cur_s = -1;
        f32x4 B0[4], SH[4];
        f32x4 xa[2][4], xb[2][4];
        ld_f32row(xa[0], x_row(F, m0), F.lane); ld_f32row(xa[1], x_row(F, m0 + 1), F.lane);
#define H_COMPUTE(X, mm) do { const int s_ = (mm) / SEQ; \
            if (s_ != cur_s) { cur_s = s_; const float* md = F.mod + (size_t)s_ * NMOD; \
                _Pragma("unroll") for (int j = 0; j < 4; ++j) { const int c = 4 * F.lane + 256 * j; \
                    B0[j] = *(const f32x4*)(F.g_mix_pre + c) * (*(const f32x4*)(md + DM + c) + 1.0f); SH[j] = *(const f32x4*)(md + c); } } \
            float q0 = sumsq4(X[0]), q1 = sumsq4(X[1]); \
            _Pragma("unroll") for (int o = 1; o < 64; o <<= 1) { q0 += __shfl_xor(q0, o); q1 += __shfl_xor(q1, o); } \
            const float r0 = 1.0f / sqrtf(q0 * (1.0f / DM) + EPS), r1 = 1.0f / sqrtf(q1 * (1.0f / DM) + EPS); \
            f32x4 o0[4], o1[4]; \
            _Pragma("unroll") for (int j = 0; j < 4; ++j) { o0[j] = X[0][j] * r0 * B0[j] + SH[j]; o1[j] = X[1][j] * r1 * B0[j] + SH[j]; } \
            st_bf16row(F.H + (size_t)(mm) * DM, o0, F.lane); st_bf16row(F.H + (size_t)((mm) + 1) * DM, o1, F.lane); } while (0)
        for (int p = 0; p < ROWS_PER_CHUNK; p += 4) {
            ld_f32row(xb[0], x_row(F, m0 + p + 2), F.lane); ld_f32row(xb[1], x_row(F, m0 + p + 3), F.lane);
            H_COMPUTE(xa, m0 + p);
            if (p + 4 < ROWS_PER_CHUNK) { ld_f32row(xa[0], x_row(F, m0 + p + 4), F.lane); ld_f32row(xa[1], x_row(F, m0 + p + 5), F.lane); }
            H_COMPUTE(xb, m0 + p + 2);
        }
#undef H_COMPUTE
    }
}
__device__ __forceinline__ void phase_mid(Frame& F, const bf16* mix) {
    bf16* X1 = (bf16*)(F.ws + WS_X1);
    const int gw = F.vcu * 8 + F.wave, NGW = F.G * 8;
    for (int ch = gw; ch < MTOK / ROWS_PER_CHUNK; ch += NGW) {
        const int m0 = ch * ROWS_PER_CHUNK; int cur_s = -1;
        f32x4 A1[4], B1[4], SH[4];
        f32x4 xa[2][4], xb[2][4]; v2u ma[2][4], mb[2][4];
        ld_f32row(xa[0], x_row(F, m0), F.lane); ld_f32row(xa[1], x_row(F, m0 + 1), F.lane);
        ld_bf16row(ma[0], mix + (size_t)m0 * DM, F.lane); ld_bf16row(ma[1], mix + (size_t)(m0 + 1) * DM, F.lane);
#define M_COMPUTE(X, MX, mm) do { const int s_ = (mm) / SEQ; \
            if (s_ != cur_s) { cur_s = s_; const float* md = F.mod + (size_t)s_ * NMOD; \
                _Pragma("unroll") for (int j = 0; j < 4; ++j) { const int c = 4 * F.lane + 256 * j; \
                    A1[j] = *(const f32x4*)(F.g_mix_post + c) * *(const f32x4*)(md + 2 * DM + c); \
                    B1[j] = *(const f32x4*)(F.g_ffn_pre + c) * (*(const f32x4*)(md + 4 * DM + c) + 1.0f); SH[j] = *(const f32x4*)(md + 3 * DM + c); } } \
            f32x4 a0[4], a1[4]; cvt_bf16row(a0, MX[0]); cvt_bf16row(a1, MX[1]); \
            float q0 = sumsq4(a0), q1 = sumsq4(a1); \
            _Pragma("unroll") for (int o = 1; o < 64; o <<= 1) { q0 += __shfl_xor(q0, o); q1 += __shfl_xor(q1, o); } \
            const float r0 = 1.0f / sqrtf(q0 * (1.0f / DM) + EPS), r1 = 1.0f / sqrtf(q1 * (1.0f / DM) + EPS); \
            _Pragma("unroll") for (int j = 0; j < 4; ++j) { a0[j] = X[0][j] + A1[j] * (a0[j] * r0); a1[j] = X[1][j] + A1[j] * (a1[j] * r1); } \
            st_bf16row(X1 + (size_t)(mm) * DM, a0, F.lane); st_bf16row(X1 + (size_t)((mm) + 1) * DM, a1, F.lane); \
            q0 = sumsq4(a0); q1 = sumsq4(a1); \
            _Pragma("unroll") for (int o = 1; o < 64; o <<= 1) { q0 += __shfl_xor(q0, o); q1 += __shfl_xor(q1, o); } \
            const float t0 = 1.0f / sqrtf(q0 * (1.0f / DM) + EPS), t1 = 1.0f / sqrtf(q1 * (1.0f / DM) + EPS); \
            _Pragma("unroll") for (int j = 0; j < 4; ++j) { a0[j] = a0[j] * t0 * B1[j] + SH[j]; a1[j] = a1[j] * t1 * B1[j] + SH[j]; } \
            st_bf16row(F.H + (size_t)(mm) * DM, a0, F.lane); st_bf16row(F.H + (size_t)((mm) + 1) * DM, a1, F.lane); } while (0)
        for (int p = 0; p < ROWS_PER_CHUNK; p += 4) {
            ld_f32row(xb[0], x_row(F, m0 + p + 2), F.lane); ld_f32row(xb[1], x_row(F, m0 + p + 3), F.lane);
            ld_bf16row(mb[0], mix + (size_t)(m0 + p + 2) * DM, F.lane); ld_bf16row(mb[1], mix + (size_t)(m0 + p + 3) * DM, F.lane);
            M_COMPUTE(xa, ma, m0 + p);
            if (p + 4 < ROWS_PER_CHUNK) { ld_f32row(xa[0], x_row(F, m0 + p + 4), F.lane); ld_f32row(xa[1], x_row(F, m0 + p + 5), F.lane);
                ld_bf16row(ma[0], mix + (size_t)(m0 + p + 4) * DM, F.lane); ld_bf16row(ma[1], mix + (size_t)(m0 + p + 5) * DM, F.lane); }
            M_COMPUTE(xb, mb, m0 + p + 2);
        }
#undef M_COMPUTE
    }
}
__device__ __forceinline__ void phase_final(Frame& F, const bf16* ffn) {
    const bf16* X1 = (const bf16*)(F.ws + WS_X1);
    const int gw = F.vcu * 8 + F.wave, NGW = F.G * 8;
    for (int ch = gw; ch < MTOK / ROWS_PER_CHUNK; ch += NGW) {
        const int m0 = ch * ROWS_PER_CHUNK; int cur_s = -1;
        f32x4 A2[4];
        v2u xa[2][4], xb[2][4]; v2u ma[2][4], mb[2][4];
        ld_bf16row(xa[0], X1 + (size_t)m0 * DM, F.lane); ld_bf16row(xa[1], X1 + (size_t)(m0 + 1) * DM, F.lane);
        ld_bf16row(ma[0], ffn + (size_t)m0 * DM, F.lane); ld_bf16row(ma[1], ffn + (size_t)(m0 + 1) * DM, F.lane);
#define F_COMPUTE(X, MX, mm) do { const int s_ = (mm) / SEQ; \
            if (s_ != cur_s) { cur_s = s_; const float* md = F.mod + (size_t)s_ * NMOD; \
                _Pragma("unroll") for (int j = 0; j < 4; ++j) { const int c = 4 * F.lane + 256 * j; \
                    A2[j] = *(const f32x4*)(F.g_ffn_post + c) * *(const f32x4*)(md + 5 * DM + c); } } \
            f32x4 a0[4], a1[4], x0[4], x1_[4]; cvt_bf16row(a0, MX[0]); cvt_bf16row(a1, MX[1]); cvt_bf16row(x0, X[0]); cvt_bf16row(x1_, X[1]); \
            float q0 = sumsq4(a0), q1 = sumsq4(a1); \
            _Pragma("unroll") for (int o = 1; o < 64; o <<= 1) { q0 += __shfl_xor(q0, o); q1 += __shfl_xor(q1, o); } \
            const float r0 = 1.0f / sqrtf(q0 * (1.0f / DM) + EPS), r1 = 1.0f / sqrtf(q1 * (1.0f / DM) + EPS); \
            _Pragma("unroll") for (int j = 0; j < 4; ++j) { a0[j] = x0[j] + A2[j] * (a0[j] * r0); a1[j] = x1_[j] + A2[j] * (a1[j] * r1); } \
            st_f32row(F.out + (size_t)(mm) * DM, a0, F.lane); st_f32row(F.out + (size_t)((mm) + 1) * DM, a1, F.lane); } while (0)
        for (int p = 0; p < ROWS_PER_CHUNK; p += 4) {
            ld_bf16row(xb[0], X1 + (size_t)(m0 + p + 2) * DM, F.lane); ld_bf16row(xb[1], X1 + (size_t)(m0 + p + 3) * DM, F.lane);
            ld_bf16row(mb[0], ffn + (size_t)(m0 + p + 2) * DM, F.lane); ld_bf16row(mb[1], ffn + (size_t)(m0 + p + 3) * DM, F.lane);
            F_COMPUTE(xa, ma, m0 + p);
            if (p + 4 < ROWS_PER_CHUNK) { ld_bf16row(xa[0], X1 + (size_t)(m0 + p + 4) * DM, F.lane); ld_bf16row(xa[1], X1 + (size_t)(m0 + p + 5) * DM, F.lane);
                ld_bf16row(ma[0], ffn + (size_t)(m0 + p + 4) * DM, F.lane); ld_bf16row(ma[1], ffn + (size_t)(m0 + p + 5) * DM, F.lane); }
            F_COMPUTE(xb, mb, m0 + p + 2);
        }
#undef F_COMPUTE
    }
}
__device__ __forceinline__ void phase_fixup(Frame& F, bf16* Gout) {
    const int gw = F.vcu * 8 + F.wave, NGW = F.G * 8;
    auto fix = [&](int b, int which) {
        const int tok = 128 * b + (which ? 127 : 0);
        if (which == 0 && (tok & (SEQ - 1)) == 0) return;
        if (which == 1 && (tok & (SEQ - 1)) == SEQ - 1) return;
        const float* P = F.edge + (size_t)(b * 2 + which) * 4 * DFF;
        const float* Nb = which ? F.edge + (size_t)((b + 1) * 2 + 0) * 4 * DFF : F.edge + (size_t)((b - 1) * 2 + 1) * 4 * DFF;
        const float* cwv = F.conv_w + (which ? 2 * NUP : 0);
        for (int c4 = F.lane; c4 < DFF / 4; c4 += 64) { const int c = 4 * c4;
            const f32x4 pv = *(const f32x4*)(P + c), pg = *(const f32x4*)(P + DFF + c), uv = *(const f32x4*)(Nb + 2 * DFF + c), ug = *(const f32x4*)(Nb + 3 * DFF + c);
            const f32x4 wv = *(const f32x4*)(cwv + c), wg = *(const f32x4*)(cwv + DFF + c);
            const f32x4 cv = pv + wv * uv, cg = pg + wg * ug;
            const float o0 = gelu_tanh(cg.x) * cv.x, o1 = gelu_tanh(cg.y) * cv.y, o2 = gelu_tanh(cg.z) * cv.z, o3 = gelu_tanh(cg.w) * cv.w;
            *(v2u*)(Gout + (size_t)tok * DFF + c) = (v2u){pk2(o0, o1), pk2(o2, o3)}; }
    };
    if (F.G == 256) { const int li = (F.vcu & 31) * 8 + F.wave; if (li < 96) fix((F.vcu >> 5) * 48 + (li >> 1), li & 1); }
    else for (int it = gw; it < 384 * 2; it += NGW) fix(it >> 1, it & 1);
}

namespace att {
constexpr int WLDS = 16384;
constexpr int SLOT = 8192, VOFF = 4096, OSTG = 8192, OSTR = 144;
constexpr int RPB_OFF = 8 * WLDS, RPB_STRIDE = 466;
static_assert(RPB_OFF + 8 * RPB_STRIDE * 4 <= MISC_OFF, "attention LDS map");
__device__ __forceinline__ int crow(int r, int hi) { return (r & 3) + 8 * (r >> 2) + 4 * hi; }
__device__ __forceinline__ s16x4 vtr(const LAS unsigned char* p) { typedef short v4i16_t __attribute__((ext_vector_type(4))); return __builtin_bit_cast(s16x4, __builtin_amdgcn_ds_read_tr16_b64_v4i16((LAS v4i16_t*)p)); }

struct State { f32x16 o[2]; float m, l; };

__device__ __forceinline__ unsigned apos(int t) { return (unsigned)((t & 3) * 512 + ((t >> 2) & 3) * 128 + (t >> 4)); }
__device__ __forceinline__ void dma_tile(LAS unsigned char* slot, const char* Kh, const char* Vh, const unsigned (&rb)[4], int lane) {
    const unsigned kc = (unsigned)(((lane & 7) ^ (lane >> 3)) << 4), vc = (unsigned)((lane & 7) << 4);
#pragma unroll
    for (int i = 0; i < 4; ++i) {
        __builtin_amdgcn_global_load_lds((const unsigned*)(Kh + (rb[i] + kc)), (LAS unsigned*)(slot + i * 1024), 16, 0, 0);
        __builtin_amdgcn_global_load_lds((const unsigned*)(Vh + (rb[i] + vc)), (LAS unsigned*)(slot + VOFF + i * 1024), 16, 0, 0); }
}
#define ATT_WAIT_DMA() asm volatile("s_waitcnt vmcnt(0)" ::: "memory")
__device__ __forceinline__ f32x16 qk(const LAS unsigned char* ks, const bf16x8 (&qf)[4], int r32, int hi) {
    f32x16 p = f32x16{};
    const LAS unsigned char* kr = ks + r32 * 128;
#pragma unroll
    for (int s = 0; s < 4; ++s) { const bf16x8 kf = *(const LAS bf16x8*)(kr + ((((2 * s + hi) ^ (r32 & 7))) << 4)); p = __builtin_amdgcn_mfma_f32_32x32x16_bf16(kf, qf[s], p, 0, 0, 0); }
    return p;
}
constexpr float THR = 8.0f;
__device__ __forceinline__ float xmax2(float v) {
    const auto r = __builtin_amdgcn_permlane32_swap(__float_as_uint(v), __float_as_uint(v), false, false); return fmaxf(__uint_as_float(r[0]), __uint_as_float(r[1])); }
__device__ __forceinline__ float xsum2(float v) {
    const auto r = __builtin_amdgcn_permlane32_swap(__float_as_uint(v), __float_as_uint(v), false, false); return __uint_as_float(r[0]) + __uint_as_float(r[1]); }
__device__ __forceinline__ void softmax_blk(State& st, f32x16& p, bf16x8& pa0, bf16x8& pa1, bool fresh_first) {
    float rm = fmaxf(fmaxf(p[0], p[1]), p[2]);
#pragma unroll
    for (int r = 3; r < 15; r += 2) rm = fmaxf(fmaxf(rm, p[r]), p[r + 1]);
    rm = fmaxf(rm, p[15]);
    rm = xmax2(rm);
    if (fresh_first || __any(rm > THR)) {
        const float delta = fresh_first ? ((rm > -1e29f) ? rm : 0.f) : fmaxf(rm, 0.f);
        const float f = fast_exp2(-delta);
        st.m += delta; st.l *= f;
#pragma unroll
        for (int r = 0; r < 16; ++r) { p[r] -= delta; st.o[0][r] *= f; st.o[1][r] *= f; }
    }
    float rs0 = 0.f, rs1 = 0.f;
#pragma unroll
    for (int r = 0; r < 16; r += 2) { p[r] = fast_exp2(p[r]); p[r + 1] = fast_exp2(p[r + 1]); rs0 += p[r]; rs1 += p[r + 1]; }
    st.l += rs0 + rs1;
    v4u pw0, pw1;
    pw0.x = pk2(p[0], p[1]); pw0.y = pk2(p[2], p[3]); pw0.z = pk2(p[4], p[5]); pw0.w = pk2(p[6], p[7]);
    pw1.x = pk2(p[8], p[9]); pw1.y = pk2(p[10], p[11]); pw1.z = pk2(p[12], p[13]); pw1.w = pk2(p[14], p[15]);
    pa0 = __builtin_bit_cast(bf16x8, pw0); pa1 = __builtin_bit_cast(bf16x8, pw1);
}
__device__ __forceinline__ void pv2(State& s0, State& s1, const bf16x8 (&pa)[2][2], const LAS unsigned char* vs, int lane, int hi) {
    const LAS unsigned char* vb = vs + (4 * hi + ((lane & 15) >> 2)) * 128 + (((lane >> 4) & 1) * 16 + (lane & 3) * 4) * 2;
    s16x4 lo[2][2], hh[2][2];
#pragma unroll
    for (int dh = 0; dh < 2; ++dh)
#pragma unroll
        for (int s = 0; s < 2; ++s) { lo[dh][s] = vtr(vb + s * 2048 + dh * 64); hh[dh][s] = vtr(vb + s * 2048 + 1024 + dh * 64); }
    __builtin_amdgcn_sched_barrier(0);
#pragma unroll
    for (int dh = 0; dh < 2; ++dh)
#pragma unroll
        for (int s = 0; s < 2; ++s) {
            const bf16x8 vf = (bf16x8){lo[dh][s][0], lo[dh][s][1], lo[dh][s][2], lo[dh][s][3], hh[dh][s][0], hh[dh][s][1], hh[dh][s][2], hh[dh][s][3]};
            s0.o[dh] = __builtin_amdgcn_mfma_f32_32x32x16_bf16(vf, pa[0][s], s0.o[dh], 0, 0, 0);
            s1.o[dh] = __builtin_amdgcn_mfma_f32_32x32x16_bf16(vf, pa[1][s], s1.o[dh], 0, 0, 0);
        }
}
__device__ __forceinline__ void qk2(f32x16& p0, f32x16& p1, float m0, float m1, const LAS unsigned char* ks, const bf16x8 (&q0)[4], const bf16x8 (&q1)[4], int r32, int hi) {
    const LAS unsigned char* kr = ks + r32 * 128;
    bf16x8 kf[4];
#pragma unroll
    for (int s = 0; s < 4; ++s) kf[s] = *(const LAS bf16x8*)(kr + ((((2 * s + hi) ^ (r32 & 7))) << 4));
#pragma unroll
    for (int r = 0; r < 16; ++r) { p0[r] = -m0; p1[r] = -m1; }
    __builtin_amdgcn_sched_barrier(0);
#pragma unroll
    for (int s = 0; s < 4; ++s) { p0 = __builtin_amdgcn_mfma_f32_32x32x16_bf16(kf[s], q0[s], p0, 0, 0, 0); p1 = __builtin_amdgcn_mfma_f32_32x32x16_bf16(kf[s], q1[s], p1, 0, 0, 0); }
}
template <class TokOf>
__device__ __forceinline__ void finish(State& st, LAS unsigned char* stg, int lane, int hi, bf16* H, unsigned Obase_b, TokOf tok_of, float* lse_ptr  ) {
    const int r32 = lane & 31;
    const float lt = xsum2(st.l);
    const float rl = fast_rcp(lt);
    if (lse_ptr && hi == 0) *lse_ptr = st.m + log2f(lt);
#pragma unroll
    for (int dh = 0; dh < 2; ++dh)
#pragma unroll
        for (int g = 0; g < 4; ++g) { v2u w; w.x = pk2(st.o[dh][4 * g] * rl, st.o[dh][4 * g + 1] * rl); w.y = pk2(st.o[dh][4 * g + 2] * rl, st.o[dh][4 * g + 3] * rl);
            *(LAS v2u*)(stg + r32 * OSTR + (32 * dh + 8 * g + 4 * hi) * 2) = w; }
#pragma unroll
    for (int i = 0; i < 4; ++i) { const int row = i * 8 + (lane >> 3), ch = lane & 7; const v4u v = *(const LAS v4u*)(stg + row * OSTR + ch * 16);
        *(v4u*)((char*)H + (Obase_b + (unsigned)tok_of(row) * (unsigned)(DM * 2) + (unsigned)(ch * 16))) = v; }
}
struct ResumeRaw { v4u row[4]; float lse; };
template <class TokOf>
__device__ __forceinline__ void resume_load(ResumeRaw& R, int lane, const bf16* H, unsigned Obase_b, TokOf tok_of, const float* lse_ptr) {
#pragma unroll
    for (int i = 0; i < 4; ++i) { const int row = i * 8 + (lane >> 3), ch = lane & 7;
        R.row[i] = *(const v4u*)((const char*)H + (Obase_b + (unsigned)tok_of(row) * (unsigned)(DM * 2) + (unsigned)(ch * 16))); }
    R.lse = *lse_ptr;
}
__device__ __forceinline__ void resume_apply(State& st, const ResumeRaw& R, LAS unsigned char* stg, int lane, int hi) {
    const int r32 = lane & 31;
#pragma unroll
    for (int i = 0; i < 4; ++i) { const int row = i * 8 + (lane >> 3), ch = lane & 7; *(LAS v4u*)(stg + row * OSTR + ch * 16) = R.row[i]; }
    st.m = R.lse; st.l = (hi == 0) ? 1.0f : 0.0f;
#pragma unroll
    for (int dh = 0; dh < 2; ++dh)
#pragma unroll
        for (int g = 0; g < 4; ++g) { const v2u w = *(const LAS v2u*)(stg + r32 * OSTR + (32 * dh + 8 * g + 4 * hi) * 2);
            st.o[dh][4 * g] = bf_lo(w.x); st.o[dh][4 * g + 1] = bf_hi(w.x); st.o[dh][4 * g + 2] = bf_lo(w.y); st.o[dh][4 * g + 3] = bf_hi(w.y); }
}

__device__ __forceinline__ void item_dilated(Frame& F, LAS unsigned char* wl, int b, int h, int d, int nb, int idx, bool first, bool lastp) {
    int tid_ = threadIdx.x; asm volatile("" : "+v"(tid_)); asm volatile("" : "+s"(wl));
    const int lane = tid_ & 63, r32 = lane & 31, hi = lane >> 5;
    const int nbp = nb >> 1, r = idx / nbp, jb = 2 * (idx % nbp);
    const size_t tbase = (size_t)b * SEQ + r;
    const bf16* qkv = F.QKV; asm volatile("" : "+s"(qkv));
    constexpr size_t TSZ = (size_t)NSEQ * 8 * SEQ * 64;
    const size_t bh_off = (size_t)(b * 8 + h) * SEQ * 64;
    const char* Qh = (const char*)(qkv + 0 * TSZ + bh_off); const char* Kh = (const char*)(qkv + 1 * TSZ + bh_off); const char* Vh = (const char*)(qkv + 2 * TSZ + bh_off);
    const size_t tq0 = tbase + (size_t)d * (32 * jb + r32), tq1 = tq0 + (size_t)d * 32;
    bf16x8 q0[4], q1[4];
    { const unsigned p0_ = apos(r + d * (32 * jb + r32)) * 128u, p1_ = apos(r + d * (32 * jb + 32 + r32)) * 128u;
#pragma unroll
      for (int s = 0; s < 4; ++s) { q0[s] = *(const bf16x8*)(Qh + p0_ + (16 * s + 8 * hi) * 2); q1[s] = *(const bf16x8*)(Qh + p1_ + (16 * s + 8 * hi) * 2); } }
    const int jt0 = jb - 2 < 0 ? 0 : jb - 2, jt1 = jb + 3 > nb - 1 ? nb - 1 : jb + 3;
#define DIL_DMA(slot_, jj) do { unsigned rb_[4]; _Pragma("unroll") for (int i_ = 0; i_ < 4; ++i_) rb_[i_] = apos(r + d * (32 * (jj) + 8 * i_ + (lane >> 3))) * 128u; dma_tile(slot_, Kh, Vh, rb_, lane); } while (0)
    float* lse0 = F.lse + (unsigned)(tq0 * 8 + h); float* lse1 = F.lse + (unsigned)(tq1 * 8 + h);
    const unsigned tok0 = (unsigned)tbase + (unsigned)(d * 32 * jb);
    auto tok_of0 = [&](int q) { return tok0 + (unsigned)(d * q); };
    auto tok_of1 = [&](int q) { return tok0 + (unsigned)(d * (32 + q)); };
    const unsigned ob = (unsigned)h * 128u;
    ResumeRaw R0, R1;
    if (!first) { resume_load(R0, lane, F.H, ob, tok_of0, lse0); resume_load(R1, lane, F.H, ob, tok_of1, lse1); }
    DIL_DMA(wl + ((jt0 & 1) ? SLOT : 0), jt0);
    State s0, s1;
    if (first) { s0.o[0] = f32x16{}; s0.o[1] = f32x16{}; s0.m = 0.f; s0.l = 0.f; s1 = s0; }
    else { LAS unsigned char* stg = wl + ((jt0 & 1) ? 0 : SLOT);
        resume_apply(s0, R0, stg, lane, hi); asm volatile("s_waitcnt lgkmcnt(0)" ::: "memory"); __builtin_amdgcn_sched_barrier(0);
        resume_apply(s1, R1, stg, lane, hi); asm volatile("s_waitcnt lgkmcnt(0)" ::: "memory"); __builtin_amdgcn_sched_barrier(0); }
    for (int jt = jt0; jt <= jt1; ++jt) {
        LAS unsigned char* ks = wl + ((jt & 1) ? SLOT : 0); LAS unsigned char* vs = ks + VOFF;
        ATT_WAIT_DMA();
        if (jt < jt1) DIL_DMA(wl + ((jt & 1) ? 0 : SLOT), jt + 1);
        f32x16 p0, p1; qk2(p0, p1, s0.m, s1.m, ks, q0, q1, r32, hi);
        const int dt0 = jt - jb, dt1 = dt0 - 1;
#define DIL_MASK(P, DT) do { \
            if ((DT) == -2) { asm volatile("" ::: "memory"); _Pragma("unroll") for (int rr = 0; rr < 16; ++rr) P[rr] = (crow(rr, hi) >= r32) ? P[rr] : -1e30f; } \
            else if ((DT) == 2) { asm volatile("" ::: "memory"); _Pragma("unroll") for (int rr = 0; rr < 16; ++rr) P[rr] = (crow(rr, hi) <= r32) ? P[rr] : -1e30f; } \
            else if ((DT) < -2 || (DT) > 2) { asm volatile("" ::: "memory"); _Pragma("unroll") for (int rr = 0; rr < 16; ++rr) P[rr] = -1e30f; } } while (0)
        DIL_MASK(p0, dt0); DIL_MASK(p1, dt1);
#undef DIL_MASK
        bf16x8 pa[2][2];
        softmax_blk(s0, p0, pa[0][0], pa[0][1], first && jt == jt0); softmax_blk(s1, p1, pa[1][0], pa[1][1], first && jt == jt0);
        pv2(s0, s1, pa, vs, lane, hi);
    }
    finish(s0, wl + OSTG, lane, hi, F.H, ob, tok_of0, lastp ? nullptr : lse0);
    finish(s1, wl + OSTG, lane, hi, F.H, ob, tok_of1, lastp ? nullptr : lse1);
}

__device__ __forceinline__ void item_neigh(Frame& F, LAS unsigned char* wl, const LAS float* rpbL, int b, int h, int idx) {
    int tid_ = threadIdx.x; asm volatile("" : "+v"(tid_)); asm volatile("" : "+s"(wl));
    const int lane = tid_ & 63, r32 = lane & 31, hi = lane >> 5;
    const int rq = idx >> 2, cb = idx & 3;
    const bf16* qkv = F.QKV; asm volatile("" : "+s"(qkv));
    constexpr size_t TSZ = (size_t)NSEQ * 8 * SEQ * 64;
    const size_t bh_off = (size_t)(b * 8 + h) * SEQ * 64;
    const char* Qh = (const char*)(qkv + 3 * TSZ + bh_off); const char* Kh = (const char*)(qkv + 4 * TSZ + bh_off); const char* Vh = (const char*)(qkv + 5 * TSZ + bh_off);
    const int qrow0 = 4 * rq + (r32 >> 4), qrow1 = qrow0 + 2, qcol = 16 * cb + (r32 & 15);
    const size_t sb = (size_t)b * SEQ;
    bf16x8 q0[4], q1[4];
    { const unsigned p0_ = (unsigned)(qrow0 * 64 + qcol) * 128u, p1_ = p0_ + 128u * 128u;
#pragma unroll
      for (int s = 0; s < 4; ++s) { q0[s] = *(const bf16x8*)(Qh + p0_ + (16 * s + 8 * hi) * 2); q1[s] = *(const bf16x8*)(Qh + p1_ + (16 * s + 8 * hi) * 2); } }
    auto clip = [](int v, int lo, int hi_) { return v < lo ? lo : (v > hi_ ? hi_ : v); };
    const int kr0 = clip(4 * rq - 4, 0, 24), krl = clip(4 * rq + 3 - 4, 0, 24) + 7;
    const int rs_0 = clip(qrow0 - 4, 0, 24), rs_1 = clip(qrow1 - 4, 0, 24), my_cs = clip(qcol - 8, 0, 48);
    const int span0 = clip(16 * cb - 8, 0, 32);
    State s0, s1; s0.o[0] = f32x16{}; s0.o[1] = f32x16{}; s0.m = 0.f; s0.l = 0.f; s1 = s0;
    const LAS float* bh = rpbL + h * RPB_STRIDE;
#define NB_DMA(slot_, kk_) do { unsigned rb_[4]; _Pragma("unroll") for (int i_ = 0; i_ < 4; ++i_) rb_[i_] = (unsigned)((kk_) * 64 + span0 + 8 * i_ + (lane >> 3)) * 128u; dma_tile(slot_, Kh, Vh, rb_, lane); } while (0)
    NB_DMA(wl + ((kr0 & 1) ? SLOT : 0), kr0);
    int boff[16];
#pragma unroll
    for (int rr = 0; rr < 16; ++rr) { const int kc = span0 + crow(rr, hi); boff[rr] = (kc >= my_cs && kc < my_cs + 16) ? crow(rr, hi) : 1000; }
    const int cbi = span0 - qcol + 15;
    for (int kr = kr0; kr <= krl; ++kr) {
        LAS unsigned char* ks = wl + ((kr & 1) ? SLOT : 0); LAS unsigned char* vs = ks + VOFF;
        ATT_WAIT_DMA();
        if (kr < krl) NB_DMA(wl + ((kr & 1) ? 0 : SLOT), kr + 1);
        f32x16 p0, p1; qk2(p0, p1, s0.m, s1.m, ks, q0, q1, r32, hi);
        const bool ok0 = (kr >= rs_0) && (kr < rs_0 + 8), ok1 = (kr >= rs_1) && (kr < rs_1 + 8);
        const int b0 = ok0 ? (kr - qrow0 + 7) * 31 + cbi : 1000, b1 = ok1 ? (kr - qrow1 + 7) * 31 + cbi : 1000;
#pragma unroll
        for (int rr = 0; rr < 16; ++rr) { const int i0 = min(b0 + boff[rr], 465), i1 = min(b1 + boff[rr], 465); p0[rr] += bh[i0]; p1[rr] += bh[i1]; }
        bf16x8 pa[2][2];
        softmax_blk(s0, p0, pa[0][0], pa[0][1], kr == kr0); softmax_blk(s1, p1, pa[1][0], pa[1][1], kr == kr0);
        pv2(s0, s1, pa, vs, lane, hi);
    }
    auto tok_of0 = [&](int q) { return (unsigned)sb + (unsigned)((4 * rq + (q >> 4)) * 64 + 16 * cb + (q & 15)); };
    auto tok_of1 = [&](int q) { return (unsigned)sb + (unsigned)((4 * rq + 2 + (q >> 4)) * 64 + 16 * cb + (q & 15)); };
    finish(s0, wl + OSTG, lane, hi, F.H, 1024u + (unsigned)h * 128u, tok_of0, nullptr);
    finish(s1, wl + OSTG, lane, hi, F.H, 1024u + (unsigned)h * 128u, tok_of1, nullptr);
}

__device__ __forceinline__ void phase_attn(Frame& F, int which) {
    LAS unsigned char* wl = F.lds + F.wave * WLDS;
    const int gw = F.vcu * 8 + F.wave, NGW = F.G * 8;
    constexpr int NITEMS = NSEQ * 8 * 32;
    if (which == 0) {
        LAS float* rpbL = (LAS float*)(F.lds + RPB_OFF);
        for (int i = F.tid; i < 8 * RPB_STRIDE; i += 512) { const int hh = i / RPB_STRIDE, e = i - hh * RPB_STRIDE; rpbL[i] = (e < 465) ? F.rpb[hh * 465 + e] * LOG2E : -1e30f; }
        __syncthreads();
        for (int it = gw; it < NITEMS; it += NGW) { int bh = it >> 5; const int idx = ((it & 31) + 11 * (it >> 11)) & 31; if (F.G == 256) bh = ((F.vcu >> 5) * 3 + (it >> 11)) * 8 + ((F.vcu & 31) >> 2);     item_neigh(F, wl, rpbL, bh >> 3, bh & 7, idx); }
        for (int it = gw; it < NITEMS; it += NGW) { int bh = it >> 5; const int idx = ((it & 31) + 11 * (it >> 11)) & 31; if (F.G == 256) bh = ((F.vcu >> 5) * 3 + (it >> 11)) * 8 + ((F.vcu & 31) >> 2);     item_dilated(F, wl, bh >> 3, bh & 7, 1, 64, idx, true, false); }
    } else if (which == 1) {
        for (int it = gw; it < NITEMS; it += NGW) { int bh = it >> 5; const int idx = ((it & 31) + 11 * (it >> 11)) & 31; if (F.G == 256) bh = ((F.vcu >> 5) * 3 + (it >> 11)) * 8 + ((F.vcu & 31) >> 2);     item_dilated(F, wl, bh >> 3, bh & 7, 4, 16, idx, false, false); }
    } else {
        for (int it = gw; it < NITEMS; it += NGW) { int bh = it >> 5; const int idx = ((it & 31) + 11 * (it >> 11)) & 31; if (F.G == 256) bh = ((F.vcu >> 5) * 3 + (it >> 11)) * 8 + ((F.vcu & 31) >> 2);     item_dilated(F, wl, bh >> 3, bh & 7, 16, 4, idx, false, true); }
    }
}
}


#define XB_TMO      128
#define XB_XCNT(j)  (256  + 64 * (j))
#define XB_XSUB(j)  (1280 + 64 * (j))
#define XB_XGEN(j)  (2304 + 64 * (j))
#define XB_TOP      3328
#define XB_TOPGEN   3392
#define XCD_BAR_WORDS 3456
#define XB_SPIN_CAP (1u << 18)
__device__ __forceinline__ unsigned xb_ld(unsigned* p)              { return __hip_atomic_load(p, __ATOMIC_RELAXED, __HIP_MEMORY_SCOPE_AGENT); }
__device__ __forceinline__ unsigned xb_add(unsigned* p, unsigned v) { return __hip_atomic_fetch_add(p, v, __ATOMIC_RELAXED, __HIP_MEMORY_SCOPE_AGENT); }
__device__ __forceinline__ unsigned xb_xcc_id() { return (unsigned)__builtin_amdgcn_s_getreg((3 << 11) | 20) & 0xFu; }
#define XB_SPIN(cond, bar) do { unsigned _sp = 0; while (cond) { __builtin_amdgcn_s_sleep(1); \
    if ((++_sp & 255u) == 0u) { if (xb_ld(&(bar)[XB_TMO])) break; if (_sp > XB_SPIN_CAP) { atomicAdd(&(bar)[XB_TMO], 1u); break; } } } } while (0)
struct XcdBarrier { unsigned* bar; unsigned x; volatile LAS unsigned* st; };
__device__ __forceinline__ XcdBarrier xcd_barrier_post(unsigned* bar, volatile LAS unsigned* st) {
    XcdBarrier b; b.bar = bar; b.x = xb_xcc_id(); b.st = st;
    if (threadIdx.x == 0) (void)xb_add(&bar[XB_XCNT(b.x)], 1u);
    return b;
}
__device__ __forceinline__ void xcd_barrier_complete(unsigned* bar, unsigned x, unsigned& nloc, unsigned& nx) {
    const unsigned G = gridDim.x * gridDim.y * gridDim.z;
    unsigned sum, cnt, mine, sp = 0u;
    for (;;) {
        sum = 0u; cnt = 0u; mine = 0u;
#pragma unroll
        for (unsigned j = 0; j < 16; ++j) { const unsigned c = xb_ld(&bar[XB_XCNT(j)]); sum += c; cnt += (c > 0u) ? 1u : 0u; mine = (j == x) ? c : mine; }
        if (sum == G) break;
        __builtin_amdgcn_s_sleep(1);
        if ((++sp & 255u) == 0u) { if (xb_ld(&bar[XB_TMO])) break; if (sp > XB_SPIN_CAP) { atomicAdd(&bar[XB_TMO], 1u); break; } }
    }
    nloc = mine > 0u ? mine : 1u; nx = cnt > 0u ? cnt : 1u;
}
__device__ __forceinline__ void xcd_barrier(const XcdBarrier& b) {
    asm volatile("s_waitcnt vmcnt(0)" ::: "memory");
    __syncthreads();
    if (threadIdx.x == 0) {
        unsigned* bar = b.bar;
        __builtin_amdgcn_s_waitcnt(0);
        unsigned nloc = b.st[0], nx = b.st[1];
        if (nloc == 0u) { xcd_barrier_complete(bar, b.x, nloc, nx); b.st[0] = nloc; b.st[1] = nx; }
        const unsigned old = xb_add(&bar[XB_XSUB(b.x)], 1u);
        const unsigned gen = old / nloc;
        if (old + 1u == (gen + 1u) * nloc) {
            __builtin_amdgcn_fence(__ATOMIC_RELEASE, "agent");
            asm volatile("s_waitcnt vmcnt(0)" ::: "memory");
            const unsigned og = xb_add(&bar[XB_TOP], 1u);
            const unsigned tg = og / nx;
            if (og + 1u == (tg + 1u) * nx) xb_add(&bar[XB_TOPGEN], 1u);
            else XB_SPIN(xb_ld(&bar[XB_TOPGEN]) == tg, bar);
            __builtin_amdgcn_fence(__ATOMIC_ACQUIRE, "agent");
            xb_add(&bar[XB_XGEN(b.x)], 1u);
            asm volatile("s_waitcnt vmcnt(0)" ::: "memory");
        } else {
            XB_SPIN(xb_ld(&bar[XB_XGEN(b.x)]) == gen, bar);
            __builtin_amdgcn_fence(__ATOMIC_ACQUIRE, "agent");
            asm volatile("s_waitcnt vmcnt(0)" ::: "memory");
        }
    }
    __syncthreads();
}

#define GRP_BAR_WORD(x) (XCD_BAR_WORDS + 64 * (x))
#define GRP_BAR_WORDS (XCD_BAR_WORDS + 64 * 8)
__device__ __forceinline__ void group_barrier(unsigned* bar, unsigned nper) {
    asm volatile("s_waitcnt vmcnt(0)" ::: "memory");
    __syncthreads();
    if (threadIdx.x == 0) {
        unsigned* c = &bar[GRP_BAR_WORD(blockIdx.x & 7)];
        __builtin_amdgcn_fence(__ATOMIC_RELEASE, "agent");
        const unsigned old = xb_add(c, 1u);
        const unsigned target = (old / nper + 1u) * nper;
        XB_SPIN(xb_ld(c) < target, bar);
        __builtin_amdgcn_fence(__ATOMIC_ACQUIRE, "agent");
        asm volatile("s_waitcnt vmcnt(0)" ::: "memory");
    }
    __syncthreads();
}

struct Args { const float* in[19]; float* out; unsigned char* ws; int ph_lo, ph_hi, coop, pad; };

#define MK_FRAME(F) Frame F; F.lds = (LAS unsigned char*)lds_raw; F.tid = threadIdx.x; F.lane = F.tid & 63; F.wave = __builtin_amdgcn_readfirstlane(F.tid >> 6); \
    F.G = gridDim.x; { const int bx_ = blockIdx.x; F.vcu = (F.G % 8 == 0) ? (bx_ % 8) * (F.G / 8) + bx_ / 8 : bx_; } \
    F.xp = args.in[0]; F.xs = args.in[1]; F.cp = args.in[2]; F.cs = args.in[3]; F.w_ada = args.in[4]; F.b_ada = args.in[5]; \
    F.g_mix_pre = args.in[6]; F.g_mix_post = args.in[7]; F.g_ffn_pre = args.in[8]; F.g_ffn_post = args.in[9]; F.w_in = args.in[10]; F.rpb = args.in[11]; \
    F.w_a = args.in[12]; F.w_b = args.in[13]; F.w_out = args.in[14]; F.w_up = args.in[15]; F.conv_w = args.in[16]; F.conv_b = args.in[17]; F.w_down = args.in[18]; \
    F.out = args.out; F.ws = args.ws; \
    F.mod = (float*)(args.ws + WS_MOD); F.rope = (float*)(args.ws + WS_ROPE); F.lse = (float*)(args.ws + WS_LSE); F.edge = (float*)(args.ws + WS_EDGE); \
    F.Win_t = (bf16*)(args.ws + WS_WIN); F.Wab_t = (bf16*)(args.ws + WS_WAB); F.Wout_t = (bf16*)(args.ws + WS_WOUT); F.Wup_t = (bf16*)(args.ws + WS_WUP); F.Wdn_t = (bf16*)(args.ws + WS_WDN); \
    F.H = (bf16*)(args.ws + WS_H); F.QKV = (bf16*)(args.ws + WS_QKV); F.GATE = (bf16*)args.out; \
    bf16* MERGED = (bf16*)(args.ws + WS_QKV); bf16* MIX = (bf16*)(args.ws + WS_QKV + 96 * MiB); bf16* GFF = (bf16*)(args.ws + WS_QKV); (void)MERGED; (void)MIX; (void)GFF;

__global__ void __launch_bounds__(512, 2) fwd_kernel(Args args) {
    extern __shared__ __attribute__((aligned(16))) unsigned char lds_raw[];
    unsigned char* ws = args.ws;
    const int lo = args.ph_lo, hi = args.ph_hi; const bool coop = args.coop != 0;
    volatile LAS unsigned* MISC = (volatile LAS unsigned*)((LAS unsigned char*)lds_raw + MISC_OFF);
    if (threadIdx.x < 32) MISC[threadIdx.x] = 0u;
    __syncthreads();
    XcdBarrier bar; bar.bar = (unsigned*)(ws + WS_CTL) + 4096; bar.x = 0; bar.st = nullptr;
    if (coop) bar = xcd_barrier_post((unsigned*)(ws + WS_CTL) + 4096, MISC + 8);
#ifndef ONLY
#define ONLY -1
#endif
#define IN(k) ((ONLY < 0 || ONLY == (k)) && lo <= (k) && (k) < hi)
#define SEAM(k) do { if (coop && (k) + 1 < hi) { if ((k) == 0 || gridDim.x != 256) xcd_barrier(bar); else group_barrier(bar.bar, 32u); } } while (0)
#ifndef DUP_MASK
#define DUP_MASK 0
#endif
#define RUN(k, ...) do { if (IN(k)) { { MK_FRAME(F) __VA_ARGS__; } if ((DUP_MASK >> (k)) & 1) { xcd_barrier(bar); { MK_FRAME(F) __VA_ARGS__; } } SEAM(k); } } while (0)
    RUN(0, phase_prologue(F));
    RUN(1, phase_h(F));
    RUN(2, {
        pg8::Gemm g{F.H, F.Win_t, MTOK / 256, NIN / 256, DM, (size_t)256 * DM * 2, (size_t)128 * DM * 2};
        pg8::StaticOrder S; S.init(g.nM, g.nN, F.G, (int)blockIdx.x);
        pg8::EpiQKV E{F.QKV, F.GATE, F.rope};
        pg8::gemm_phase<pg8::EpiQKV, true, false>(F.lds, g, S, E); });
    RUN(3, att::phase_attn(F, 0));
    RUN(4, att::phase_attn(F, 1));
    RUN(5, att::phase_attn(F, 2));
    RUN(6, {
        pg8::Gemm g{F.H, F.Wab_t, MTOK / 256, DM / 256, DM, (size_t)256 * DM * 2, (size_t)128 * DM * 2};
        pg8::StaticOrder S; S.init(g.nM, g.nN, F.G, (int)blockIdx.x);
        pg8::EpiMerged E{F.GATE, MERGED};
        pg8::gemm_phase<pg8::EpiMerged, true, false>(F.lds, g, S, E); });
    RUN(7, {
        pg8::Gemm g{MERGED, F.Wout_t, MTOK / 256, DM / 256, DM, (size_t)256 * DM * 2, (size_t)128 * DM * 2};
        pg8::StaticOrder S; S.init(g.nM, g.nN, F.G, (int)blockIdx.x);
        pg8::EpiBf16 E{MIX, DM};
        pg8::gemm_phase<pg8::EpiBf16, true, false>(F.lds, g, S, E); });
    RUN(8, phase_mid(F, MIX));
    RUN(9, {
        pg8::Gemm g{F.H, F.Wup_t, MTOK / 256, DFF / 128, DM, (size_t)128 * DM * 2, (size_t)DFF * DM * 2};
        pg8::StaticOrder S; S.init(g.nM, g.nN, F.G, (int)blockIdx.x);
        pg8::EpiUp E{GFF, F.edge, F.conv_w, F.conv_b, (LAS float*)(F.lds + RING_BYTES)};
        pg8::gemm_phase<pg8::EpiUp, true, true>(F.lds, g, S, E); });
    RUN(10, phase_fixup(F, GFF));
    RUN(11, {
        pg8::Gemm g{GFF, F.Wdn_t, MTOK / 256, DM / 256, DFF, (size_t)256 * DFF * 2, (size_t)128 * DFF * 2};
        pg8::StaticOrder S; S.init(g.nM, g.nN, F.G, (int)blockIdx.x);
        pg8::EpiBf16 E{F.H, DM};
        pg8::gemm_phase<pg8::EpiBf16, true, false>(F.lds, g, S, E); });
    RUN(12, phase_final(F, F.H));
#undef RUN
#undef IN
#undef SEAM
}

extern "C" void kernel_launch(void* const* d_in, const int* in_sizes, int n_in, void* d_out, int out_size, void* d_ws, size_t ws_size, hipStream_t stream) {
    static int grid = 0;
    if (grid == 0) {
        if (n_in != 19 || out_size != MTOK * DM || ws_size < WS_END) { fprintf(stderr, "kernel_launch: unexpected sizes n_in %d out %d ws %zu\n", n_in, out_size, ws_size); grid = -1; return; }
        int dev = 0, cus = 0, per_cu = 0;
        (void)hipGetDevice(&dev); (void)hipDeviceGetAttribute(&cus, hipDeviceAttributeMultiprocessorCount, dev);
        if (hipFuncSetAttribute((const void*)fwd_kernel, hipFuncAttributeMaxDynamicSharedMemorySize, LDS_BYTES) != hipSuccess) { fprintf(stderr, "kernel_launch: hipFuncSetAttribute failed\n"); grid = -1; return; }
        if (hipOccupancyMaxActiveBlocksPerMultiprocessor(&per_cu, (const void*)fwd_kernel, 512, LDS_BYTES) != hipSuccess || per_cu < 1) { fprintf(stderr, "kernel_launch: occupancy query says %d\n", per_cu); per_cu = 1; }
        (void)hipGetLastError();
        grid = cus;
    }
    if (grid < 0) return;
    (void)hipMemsetAsync((char*)d_ws + WS_CTL + 4096 * 4, 0, GRP_BAR_WORDS * 4, stream);
    Args a{};
    for (int i = 0; i < 19; ++i) a.in[i] = (const float*)d_in[i];
    a.out = (float*)d_out; a.ws = (unsigned char*)d_ws;
#if N_LAUNCH_MODE == 1
    a.ph_lo = 0; a.ph_hi = NPH; a.coop = 1;
    void* kargs[] = {&a};
    hipError_t e = hipLaunchCooperativeKernel((const void*)fwd_kernel, dim3(grid), dim3(512), kargs, LDS_BYTES, stream);
    if (e != hipSuccess) fprintf(stderr, "cooperative launch failed: %s (grid %d)\n", hipGetErrorString(e), grid);
#else
    for (int p = 0; p < NPH; ++p) { a.ph_lo = p; a.ph_hi = p + 1; a.coop = 0;
        hipLaunchKernelGGL(fwd_kernel, dim3(grid), dim3(512), LDS_BYTES, stream, a); }
#endif
}
```

```cpp
#include <hip/hip_runtime.h>
#include <hip/hip_cooperative_groups.h>
#include <cstdio>
#include <cstdint>
namespace cg = cooperative_groups;

#ifndef N_LAUNCH_MODE
#define N_LAUNCH_MODE 1
#endif

constexpr int DM = 1024, SEQ = 2048, NSEQ = 24, NSEQ_P = 8, MTOK = NSEQ * SEQ;
constexpr int NIN = 5120, NQKV = 3072, NGATE = 2048, DFF = 2816, NUP = 2 * DFF;
constexpr int NMOD = 6 * DM;
constexpr float EPS = 1e-6f;
constexpr float LOG2E = 1.4426950408889634f;
constexpr float C2 = 0.125f * LOG2E;
constexpr int NPH = 13;

constexpr size_t MiB = 1u << 20;
constexpr size_t WS_CTL = 0, CTL_ZERO_BYTES = 1 * MiB;
constexpr size_t WS_MOD = 1 * MiB;
constexpr size_t WS_ROPE = 2 * MiB;
constexpr size_t WS_WIN = 4 * MiB;
constexpr size_t WS_WAB = 14 * MiB;
constexpr size_t WS_WOUT = 16 * MiB;
constexpr size_t WS_WUP = 18 * MiB;
constexpr size_t WS_WDN = 29 * MiB;
constexpr size_t WS_H = 36 * MiB;
constexpr size_t WS_QKV = 132 * MiB;
constexpr size_t WS_LSE = 420 * MiB;
constexpr size_t WS_EDGE = 422 * MiB;
constexpr size_t WS_X1 = 512 * MiB;
constexpr size_t WS_END = 608 * MiB;
static_assert(WS_EDGE + (size_t)384 * 2 * 4 * DFF * 4 <= WS_END, "ws map");
static_assert(WS_QKV + (size_t)MTOK * NQKV * 2 <= WS_LSE && WS_QKV + (size_t)MTOK * DFF * 2 <= WS_LSE, "ws map");

constexpr int RING_BYTES = 131072;
constexpr int LDS_BYTES = 163840;
constexpr int MISC_OFF = LDS_BYTES - 256;

#define LAS __attribute__((address_space(3)))
#define GAS __attribute__((address_space(1)))
typedef unsigned short bf16;
typedef unsigned v4u __attribute__((ext_vector_type(4)));
typedef unsigned v2u __attribute__((ext_vector_type(2)));
typedef float f32x4 __attribute__((ext_vector_type(4)));
typedef float f32x2 __attribute__((ext_vector_type(2)));
typedef double f64x2 __attribute__((ext_vector_type(2)));
typedef float f32x16 __attribute__((ext_vector_type(16)));
typedef short bf16x8 __attribute__((ext_vector_type(8)));
typedef short s16x4 __attribute__((ext_vector_type(4)));
typedef __bf16 bf16x2_t __attribute__((ext_vector_type(2)));

__device__ __forceinline__ unsigned pk2(float lo, float hi) { f32x2 v = {lo, hi}; bf16x2_t b = __builtin_convertvector(v, bf16x2_t); return __builtin_bit_cast(unsigned, b); }
__device__ __forceinline__ float bf_lo(unsigned w) { return __uint_as_float(w << 16); }
__device__ __forceinline__ float bf_hi(unsigned w) { return __uint_as_float(w & 0xffff0000u); }
__device__ __forceinline__ float wave_sum(float v) {
#pragma unroll
    for (int o = 1; o < 64; o <<= 1) v += __shfl_xor(v, o);
    return v;
}
__device__ __forceinline__ float fast_exp2(float x) { return __builtin_amdgcn_exp2f(x); }
__device__ __forceinline__ float fast_rcp(float x) { return __builtin_amdgcn_rcpf(x); }
__device__ __forceinline__ float gelu_tanh(float x) {
    const float t = x * (1.0f + 0.044715f * x * x);
    const float e = fast_exp2(t * (-2.0f * 0.7978845608028654f * LOG2E));
    return x * fast_rcp(1.0f + e);
}

namespace pg8 {
#define PG8_LAS __attribute__((address_space(3)))
typedef unsigned short bf16_t;
constexpr int BM = 256, BK = 64, HALF = 128, HTB = HALF * BK * 2, STAGE_BYTES = 8 * HTB, NXCD = 8, WGM = 8;

__host__ __device__ __forceinline__ int lds_byte(int r, int c) { const int st = (r >> 4) * 2 + (c >> 5), rr = r & 15, cc = c & 31, ob = rr * 64 + cc * 2; return st * 1024 + (ob ^ (((ob >> 9) & 1) << 5)); }
__host__ __device__ __forceinline__ void stage_rc(int b, int& R, int& C) { const int st = b / 1024, sb = b % 1024, swz = sb ^ (((sb >> 9) & 1) << 5); R = (st >> 1) * 16 + swz / 64; C = (st & 1) * 32 + (swz % 64) / 2; }
__host__ __device__ __forceinline__ int perm32(int rho) { const int n = rho >> 4, i = rho & 15; return 8 * (i >> 2) + 4 * n + (i & 3); }

struct Unit { int pm, pn; };
struct Gemm { const bf16_t* A; const bf16_t* Bt; int nM, nN, K; size_t b_tile, b_half; };

struct StaticOrder {
    int nM, nN, nwg, G, c;
    __host__ __device__ void init(int nM_, int nN_, int G_, int c_) { nM = nM_; nN = nN_; nwg = nM * nN; G = G_; c = c_; }
    __host__ __device__ bool next(int i, Unit& u) const {
        const long L = (long)i * G + c; if (L >= nwg) return false;
        int wgid = (int)L; { const int q = nwg / NXCD, r = nwg % NXCD, xcd = wgid % NXCD, off = wgid / NXCD; wgid = (xcd < r ? xcd * (q + 1) : r * (q + 1) + (xcd - r) * q) + off; }
        const int nig = WGM * nN, gid = wgid / nig, fm = gid * WGM, gsz = (nM - fm) < WGM ? (nM - fm) : WGM;
        u.pm = fm + ((wgid % nig) % gsz); u.pn = (wgid % nig) / gsz; return true;
    }
};


template <class Epi, bool ALIGN_EPI, bool AREMAP>
__device__ __forceinline__ void gemm_phase(PG8_LAS unsigned char* lds, const Gemm g, const StaticOrder& S, const Epi& E) {
    const int tid = threadIdx.x, wid = __builtin_amdgcn_readfirstlane(tid >> 6), lane = tid & 63, wr = wid >> 2, wc = wid & 3, fr = lane & 15, fq = lane >> 4;
    const int K = g.K, nt = K / BK;
    unsigned voffA[2], voffB[2];
#pragma unroll
    for (int i = 0; i < 2; ++i) { int R, C; stage_rc(tid * 16 + i * 8192, R, C); const int Rb = Epi::PERM ? ((R & ~31) + perm32(R & 31)) : R;
        const int Ra = AREMAP ? (128 * (R >> 6) + 8 * (R & 15) + ((R >> 4) & 3)) : R;
        voffA[i] = (unsigned)(Ra * K + C) * 2u; voffB[i] = (unsigned)(Rb * K + C) * 2u; }
    const size_t kstep = (size_t)(BK * 2);
    const size_t hstepA = AREMAP ? (size_t)4 * K * 2 : (size_t)HALF * K * 2;
    const size_t tstepA = (size_t)BM * K * 2;
    const size_t hstepB = g.b_half, tstepB = g.b_tile;
    const unsigned ldsw = (unsigned)wid * 1024u;
    const int aoff = lds_byte(wr * 64 + fr, fq * 8), boff = lds_byte(wc * 32 + fr, fq * 8);
#define PG8_SA(b, h) (((b) * 2 + (h)) * HTB)
#define PG8_SB(b, h) ((4 + (b) * 2 + (h)) * HTB)
#define PG8_STAGE(bufoff, gbase, voff) do { _Pragma("unroll") for (int _i = 0; _i < 2; ++_i) \
        __builtin_amdgcn_global_load_lds((const unsigned*)((const char*)(gbase) + (voff)[_i]), (PG8_LAS unsigned*)(lds + (bufoff) + ldsw + _i * 8192), 16, 0, 0); } while (0)
#define PG8_LDA(dst, b, h) do { _Pragma("unroll") for (int m = 0; m < 4; ++m) _Pragma("unroll") for (int k = 0; k < 2; ++k) dst[m][k] = *(const PG8_LAS bf16x8*)(lds + PG8_SA(b, h) + aoff + m * 2048 + k * 1024); } while (0)
#define PG8_LDB(dst, b, h) do { _Pragma("unroll") for (int n = 0; n < 2; ++n) _Pragma("unroll") for (int k = 0; k < 2; ++k) dst[n][k] = *(const PG8_LAS bf16x8*)(lds + PG8_SB(b, h) + boff + n * 2048 + k * 1024); } while (0)
#define PG8_MMA(ai, bj, At, Bt) do { __builtin_amdgcn_s_setprio(1); _Pragma("unroll") for (int m = 0; m < 4; ++m) _Pragma("unroll") for (int n = 0; n < 2; ++n) _Pragma("unroll") for (int k = 0; k < 2; ++k) \
        acc[ai][bj][m][n] = __builtin_amdgcn_mfma_f32_16x16x32_bf16(Bt[n][k], At[m][k], acc[ai][bj][m][n], 0, 0, 0); __builtin_amdgcn_s_setprio(0); } while (0)
#define PG8_WAIT_V(n) asm volatile("s_waitcnt vmcnt(" #n ")" ::: "memory")
#define PG8_WAIT_L(n) asm volatile("s_waitcnt lgkmcnt(" #n ")" ::: "memory")
#define PG8_BAR __builtin_amdgcn_s_barrier()
#define PG8_SCHED __builtin_amdgcn_sched_barrier(0)
    Unit cur, nxt; int ui = 0;
    if (!S.next(0, cur)) return;
    f32x4 acc[2][2][4][2];
#pragma unroll
    for (int a = 0; a < 2; ++a)
#pragma unroll
        for (int b = 0; b < 2; ++b)
#pragma unroll
            for (int m = 0; m < 4; ++m)
#pragma unroll
                for (int n = 0; n < 2; ++n) acc[a][b][m][n] = (f32x4){0.f, 0.f, 0.f, 0.f};
    bf16x8 At[4][2], B0[2][2], B1[2][2];
    int pf_t = 2; asm volatile("" : "+s"(pf_t));
    const char* cA = (const char*)g.A + (size_t)cur.pm * tstepA; const char* cB = (const char*)g.Bt + (size_t)cur.pn * tstepB;
    PG8_STAGE(PG8_SB(0, 0), cB, voffB); PG8_STAGE(PG8_SB(0, 1), cB + hstepB, voffB); PG8_STAGE(PG8_SA(0, 0), cA, voffA); PG8_STAGE(PG8_SA(0, 1), cA + hstepA, voffA);
    if (wr == 1) PG8_BAR;
    PG8_WAIT_V(2); PG8_BAR;
    PG8_STAGE(PG8_SB(1, 0), cB + kstep, voffB); PG8_STAGE(PG8_SA(1, 0), cA + kstep, voffA); PG8_STAGE(PG8_SB(1, 1), cB + hstepB + kstep, voffB);
    PG8_WAIT_V(6); PG8_BAR;
    for (;;) {
        const bool has_next = S.next(ui + 1, nxt);
        const char* nA = has_next ? (const char*)g.A + (size_t)nxt.pm * tstepA : cA; const char* nB = has_next ? (const char*)g.Bt + (size_t)nxt.pn * tstepB : cB;
        for (int t = 0; t < nt; t += 2) {
            const bool last = (t == nt - 2);
            const char* a1 = cA + (size_t)(t + 1) * kstep;
            const char* a2 = last ? nA : cA + (size_t)(t + 2) * kstep; const char* b2 = last ? nB : cB + (size_t)(t + 2) * kstep;
            const char* a3 = a2 + kstep; const char* b3 = b2 + kstep;
            if constexpr (Epi::MIDK) { if (t == (nt >> 1)) E.midk(acc, cur, wr, wc, fr, fq); }
            if constexpr (Epi::PREF) { if (t == pf_t) E.pf_dma(cur, wid, lane); }
            PG8_LDB(B0, 0, 0); PG8_LDB(B1, 0, 1); PG8_SCHED; PG8_LDA(At, 0, 0); PG8_STAGE(PG8_SA(1, 1), a1 + hstepA, voffA);
            PG8_WAIT_V(8); PG8_WAIT_L(0); PG8_BAR; PG8_MMA(0, 0, At, B0); PG8_MMA(0, 1, At, B1); PG8_BAR; PG8_SCHED;
            PG8_LDA(At, 0, 1); PG8_STAGE(PG8_SB(0, 0), b2, voffB); PG8_STAGE(PG8_SB(0, 1), b2 + hstepB, voffB); PG8_STAGE(PG8_SA(0, 0), a2, voffA);
            PG8_WAIT_V(8); PG8_WAIT_L(0); PG8_BAR; PG8_MMA(1, 0, At, B0); PG8_MMA(1, 1, At, B1); PG8_BAR; PG8_SCHED;
            PG8_LDB(B0, 1, 0); PG8_LDB(B1, 1, 1); PG8_SCHED; PG8_LDA(At, 1, 0); PG8_STAGE(PG8_SA(0, 1), a2 + hstepA, voffA);
            PG8_WAIT_V(8); PG8_WAIT_L(0); PG8_BAR; PG8_MMA(0, 0, At, B0); PG8_MMA(0, 1, At, B1); PG8_BAR; PG8_SCHED;
            PG8_LDA(At, 1, 1); PG8_STAGE(PG8_SB(1, 0), b3, voffB); PG8_STAGE(PG8_SB(1, 1), b3 + hstepB, voffB); PG8_STAGE(PG8_SA(1, 0), a3, voffA);
            PG8_WAIT_V(8); PG8_WAIT_L(0); PG8_BAR; PG8_MMA(1, 0, At, B0); PG8_MMA(1, 1, At, B1); PG8_BAR; PG8_SCHED;
        }
        if constexpr (ALIGN_EPI) { if (wr == 0) PG8_BAR; }
        E(acc, cur, wr, wc, fr, fq);
        if (!has_next) break;
#pragma unroll
        for (int a = 0; a < 2; ++a)
#pragma unroll
            for (int b = 0; b < 2; ++b)
#pragma unroll
                for (int m = 0; m < 4; ++m)
#pragma unroll
                    for (int n = 0; n < 2; ++n) { double z0, z1; asm volatile("v_mov_b64 %0, 0" : "=v"(z0)); asm volatile("v_mov_b64 %0, 0" : "=v"(z1));
                        const f64x2 z = {z0, z1}; acc[a][b][m][n] = __builtin_bit_cast(f32x4, z); }
        cur = nxt; cA = nA; cB = nB; ++ui;
        if constexpr (ALIGN_EPI) { if (wr == 1) PG8_BAR; }
    }
    PG8_WAIT_V(0);
    if constexpr (!ALIGN_EPI) { if (wr == 0) PG8_BAR; }
    PG8_BAR;
#undef PG8_SA
#undef PG8_SB
#undef PG8_STAGE
#undef PG8_LDA
#undef PG8_LDB
#undef PG8_MMA
#undef PG8_WAIT_V
#undef PG8_WAIT_L
#undef PG8_BAR
#undef PG8_SCHED
}

struct EpiBf16 {
    static constexpr bool PERM = true, MIDK = false, PREF = false;
    bf16_t* O; int ldc;
    __device__ __forceinline__ void operator()(const f32x4 (&acc)[2][2][4][2], const Unit& u, int wr, int wc, int fr, int fq) const {
        const int row0 = u.pm * BM + wr * 64 + fr, col0 = u.pn * BM + wc * 32 + 8 * fq;
#pragma unroll
        for (int ai = 0; ai < 2; ++ai)
#pragma unroll
            for (int m = 0; m < 4; ++m) { bf16_t* rowp = O + (size_t)(row0 + ai * HALF + m * 16) * ldc + col0;
#pragma unroll
                for (int bj = 0; bj < 2; ++bj) { const f32x4 v0 = acc[ai][bj][m][0], v1 = acc[ai][bj][m][1];
                    v4u w; w.x = pk2(v0[0], v0[1]); w.y = pk2(v0[2], v0[3]); w.z = pk2(v1[0], v1[1]); w.w = pk2(v1[2], v1[3]);
                    *(v4u*)(rowp + bj * HALF) = w; } }
    }
};

struct EpiQKV {
    static constexpr bool PERM = true, MIDK = false, PREF = false;
    bf16_t* QKV; bf16_t* G; const float* rope;
    static __device__ __forceinline__ unsigned qkv_row_elem(int T, int row, int h) {
        const int b = row >> 11, t = row & (SEQ - 1);
        const int pos = (T < 3) ? ((t & 3) * 512 + ((t >> 2) & 3) * 128 + (t >> 4)) : t;
        return (unsigned)(((T * NSEQ + b) * 8 + h) * SEQ + pos) * 64u;
    }
    __device__ __forceinline__ void operator()(const f32x4 (&acc)[2][2][4][2], const Unit& u, int wr, int wc, int fr, int fq) const {
        const int pn = u.pn;
        const float sc = (pn < 2 || pn == 6 || pn == 7) ? C2 : 1.0f;
        const int row0 = u.pm * BM + wr * 64 + fr;
        if (pn >= 12) {
            const int j_ = pn - 12, pnq = j_ >> 1, bjm = j_ & 1;
            const int hx = ((u.pm * 4 + pnq) * 37) & 127;
            bf16_t* blkR = G + ((size_t)((0 * (MTOK / 256) + u.pm) * 4 + pnq) * 65536) + (fq * 16 + fr) * 8; bf16_t* blkS = blkR + (size_t)(MTOK / 256) * 4 * 65536; const int cw = (wr * 4 + wc) * 16;
#pragma unroll
            for (int ai = 0; ai < 2; ++ai)
#pragma unroll
                for (int m = 0; m < 4; ++m) { float rr[8], ss[8];
#pragma unroll
                    for (int q = 0; q < 8; ++q) { const float ga = fminf(fmaxf(acc[ai][0][m][q >> 2][q & 3], -30.f), 30.f), gb = fminf(fmaxf(acc[ai][1][m][q >> 2][q & 3], -30.f), 30.f);
                        const float ea = fast_exp2(-LOG2E * ga), eb = fast_exp2(-LOG2E * gb); ss[q] = fast_rcp(1.f + eb); rr[q] = (1.f + eb) * fast_rcp(1.f + ea); }
                    v4u wR, wS; wR.x = pk2(rr[0], rr[1]); wR.y = pk2(rr[2], rr[3]); wR.z = pk2(rr[4], rr[5]); wR.w = pk2(rr[6], rr[7]);
                    wS.x = pk2(ss[0], ss[1]); wS.y = pk2(ss[2], ss[3]); wS.z = pk2(ss[4], ss[5]); wS.w = pk2(ss[6], ss[7]);
                    const int off = ((cw + (ai * 4 + m) * 2 + bjm) ^ hx) * 512;
                    *(v4u*)(blkR + off) = wR; *(v4u*)(blkS + off) = wS; }
        } else if (pn < 4) {
            const int T = pn >> 1, hbase = 4 * (pn & 1) + (wc >> 1), coff = 32 * (wc & 1) + 8 * fq;
            const bool rl = ((wc & 1) == 0) && (fq < 2);
            const int fqc = rl ? fq : 0;
#pragma unroll
            for (int ai = 0; ai < 2; ++ai)
#pragma unroll
                for (int m = 0; m < 4; ++m) {
                    const int row = row0 + ai * HALF + m * 16; const int pos = row & (SEQ - 1);
                    const f32x4* rp = (const f32x4*)(rope + (size_t)(pos * 8 + 4 * fqc) * 2);
                    f32x4 cs0 = rp[0], cs1 = rp[1];
                    const f32x4 ident = (f32x4){1.f, 0.f, 1.f, 0.f};
                    cs0 = rl ? cs0 : ident; cs1 = rl ? cs1 : ident;
#pragma unroll
                    for (int bj = 0; bj < 2; ++bj) {
                        bf16_t* dst = QKV + qkv_row_elem(T, row, hbase + 2 * bj) + coff;
                        const f32x4 x1 = acc[ai][bj][m][0] * sc, x2 = acc[ai][bj][m][1] * sc;
                        const float c0 = cs0[0], s0 = cs0[1], c1 = cs0[2], s1 = cs0[3], c2 = cs1[0], s2 = cs1[1], c3 = cs1[2], s3 = cs1[3];
                        unsigned ax = pk2(x1[0] * c0 - x2[0] * s0, x1[1] * c1 - x2[1] * s1), ay = pk2(x1[2] * c2 - x2[2] * s2, x1[3] * c3 - x2[3] * s3);
                        unsigned bx = pk2(x1[0] * s0 + x2[0] * c0, x1[1] * s1 + x2[1] * c1), by = pk2(x1[2] * s2 + x2[2] * c2, x1[3] * s3 + x2[3] * c3);
                        const auto rx = __builtin_amdgcn_permlane16_swap(ax, bx, false, false); const auto ry = __builtin_amdgcn_permlane16_swap(ay, by, false, false);
                        v4u w; w.x = rx[0]; w.y = ry[0]; w.z = rx[1]; w.w = ry[1];
                        *(v4u*)dst = w;
                    }
                }
        } else {
            const int T = pn >> 1, hbase = 4 * (pn & 1) + (wc >> 1), coff = 32 * (wc & 1) + 8 * fq;
#pragma unroll
            for (int ai = 0; ai < 2; ++ai)
#pragma unroll
                for (int m = 0; m < 4; ++m) {
                    const int row = row0 + ai * HALF + m * 16;
#pragma unroll
                    for (int bj = 0; bj < 2; ++bj) {
                        bf16_t* dst = QKV + qkv_row_elem(T, row, hbase + 2 * bj) + coff;
                        const f32x4 x1 = acc[ai][bj][m][0] * sc, x2 = acc[ai][bj][m][1] * sc;
                        v4u w; w.x = pk2(x1[0], x1[1]); w.y = pk2(x1[2], x1[3]); w.z = pk2(x2[0], x2[1]); w.w = pk2(x2[2], x2[3]);
                        *(v4u*)dst = w;
                    }
                }
        }
    }
};

struct EpiMerged {
    static constexpr bool PERM = true, MIDK = true, PREF = false;
    const bf16_t* G; bf16_t* O;
    static __device__ __forceinline__ float eneg(float g) { g = fminf(fmaxf(g, -30.f), 30.f); return fast_exp2(-LOG2E * g); }
    __device__ __forceinline__ void midk(f32x4 (&acc)[2][2][4][2], const Unit& u, int wr, int wc, int fr, int fq) const {
        int fr_ = fr, fq_ = fq; asm volatile("" : "+v"(fr_), "+v"(fq_));
        const int hx = ((u.pm * 4 + u.pn) * 37) & 127, cw = (wr * 4 + wc) * 16;
        const bf16_t* ba = G + ((size_t)((0 * (MTOK / 256) + u.pm) * 4 + u.pn) * 65536) + (fq_ * 16 + fr_) * 8;
        v4u rr[8][2];
#pragma unroll
        for (int g = 0; g < 8; ++g) { rr[g][0] = *(const v4u*)(ba + ((cw + g * 2 + 0) ^ hx) * 512); rr[g][1] = *(const v4u*)(ba + ((cw + g * 2 + 1) ^ hx) * 512); }
        asm volatile("" ::: "memory");
#pragma unroll
        for (int g = 0; g < 8; ++g)
#pragma unroll
            for (int bj = 0; bj < 2; ++bj)
#pragma unroll
                for (int q = 0; q < 4; ++q) { acc[g >> 2][bj][g & 3][q >> 1][(q & 1) * 2] *= bf_lo(rr[g][bj][q]); acc[g >> 2][bj][g & 3][q >> 1][(q & 1) * 2 + 1] *= bf_hi(rr[g][bj][q]); }
    }
    __device__ __forceinline__ void operator()(const f32x4 (&acc)[2][2][4][2], const Unit& u, int wr, int wc, int fr, int fq) const {
        int fr_ = fr, fq_ = fq; asm volatile("" : "+v"(fr_), "+v"(fq_));
        const int row0 = u.pm * BM + wr * 64 + fr_, col0 = u.pn * BM + wc * 32 + 8 * fq_;
        const int hx = ((u.pm * 4 + u.pn) * 37) & 127, cw = (wr * 4 + wc) * 16;
        const bf16_t* bb = G + ((size_t)((1 * (MTOK / 256) + u.pm) * 4 + u.pn) * 65536) + (fq_ * 16 + fr_) * 8;
        v4u sa[2], sb[2];
#define LDG(dst, g_) do { dst[0] = *(const v4u*)(bb + ((cw + (g_) * 2 + 0) ^ hx) * 512); dst[1] = *(const v4u*)(bb + ((cw + (g_) * 2 + 1) ^ hx) * 512); } while (0)
#define USE(src, g_) do { const size_t row = (size_t)(row0 + ((g_) >> 2) * HALF + ((g_) & 3) * 16); _Pragma("unroll") for (int bj = 0; bj < 2; ++bj) { float o[8]; \
            _Pragma("unroll") for (int q = 0; q < 4; ++q) { o[2 * q] = acc[(g_) >> 2][bj][(g_) & 3][q >> 1][(q & 1) * 2] * bf_lo(src[bj][q]); o[2 * q + 1] = acc[(g_) >> 2][bj][(g_) & 3][q >> 1][(q & 1) * 2 + 1] * bf_hi(src[bj][q]); } \
            v4u w; w.x = pk2(o[0], o[1]); w.y = pk2(o[2], o[3]); w.z = pk2(o[4], o[5]); w.w = pk2(o[6], o[7]); *(v4u*)(O + row * DM + col0 + bj * HALF) = w; } } while (0)
        LDG(sa, 0);
#pragma unroll
        for (int g = 0; g < 8; g += 2) {
            LDG(sb, g + 1); asm volatile("" ::: "memory"); USE(sa, g);
            if (g + 2 < 8) LDG(sa, g + 2); asm volatile("" ::: "memory"); USE(sb, g + 1);
        }
#undef LDG
#undef USE
    }
};

struct EpiUp {
    static constexpr bool PERM = true, MIDK = false, PREF = true;
    bf16_t* Gout; float* edge; const float* cw; const float* cb; PG8_LAS float* cl;
    static __device__ __forceinline__ float dpp_prev(float v) { return __int_as_float(__builtin_amdgcn_update_dpp(0, __float_as_int(v), 0x111, 0xf, 0xf, true)); }
    static __device__ __forceinline__ float dpp_next(float v) { return __int_as_float(__builtin_amdgcn_update_dpp(0, __float_as_int(v), 0x101, 0xf, 0xf, true)); }
    __device__ __forceinline__ void pf_dma(const Unit& u, int wid, int lane) const {
        if (wid < 4) { int l_ = lane; asm volatile("" : "+v"(l_));
            const int t_ = wid * 64 + l_, kind = t_ >> 5, c4 = t_ & 31; const float* base = ((kind & 3) == 3) ? cb : cw + (kind & 3) * NUP;
            __builtin_amdgcn_global_load_lds((const unsigned*)(base + (kind >> 2) * DFF + u.pn * 128 + 4 * c4), (PG8_LAS unsigned*)(cl + wid * 256), 16, 0, 0); }
    }
    static __device__ __forceinline__ f32x4 dpp_prev4(f32x4 v) { return (f32x4){dpp_prev(v[0]), dpp_prev(v[1]), dpp_prev(v[2]), dpp_prev(v[3])}; }
    static __device__ __forceinline__ f32x4 dpp_next4(f32x4 v) { return (f32x4){dpp_next(v[0]), dpp_next(v[1]), dpp_next(v[2]), dpp_next(v[3])}; }
    __device__ __forceinline__ void operator()(const f32x4 (&acc)[2][2][4][2], const Unit& u, int wr, int wc, int fr, int fq) const {
        const int f0 = u.pn * 128 + wc * 32 + 8 * fq;
        const int tok0 = u.pm * BM + wr * 128 + 8 * fr;
        const int blk = u.pm * 2 + wr;
        float* e0p = edge + (size_t)(blk * 2 + 0) * 4 * DFF + f0;
        float* e7p = edge + (size_t)(blk * 2 + 1) * 4 * DFF + f0;
        const PG8_LAS float* cl0 = cl + wc * 32 + 8 * fq;
        constexpr float GK = -2.0f * 0.7978845608028654f * LOG2E;
        unsigned res[8][2];
#pragma unroll
        for (int n = 0; n < 2; ++n) {
            const f32x4 w0v = *(const PG8_LAS f32x4*)(cl0 + 0 * 128 + 4 * n), w1v = *(const PG8_LAS f32x4*)(cl0 + 1 * 128 + 4 * n), w2v = *(const PG8_LAS f32x4*)(cl0 + 2 * 128 + 4 * n), bv = *(const PG8_LAS f32x4*)(cl0 + 3 * 128 + 4 * n);
            const f32x4 w0g = *(const PG8_LAS f32x4*)(cl0 + 4 * 128 + 4 * n), w1g = *(const PG8_LAS f32x4*)(cl0 + 5 * 128 + 4 * n), w2g = *(const PG8_LAS f32x4*)(cl0 + 6 * 128 + 4 * n), bg = *(const PG8_LAS f32x4*)(cl0 + 7 * 128 + 4 * n);
#define UP_V(g_) acc[(g_) >> 2][0][(g_) & 3][n]
#define UP_G(g_) acc[(g_) >> 2][1][(g_) & 3][n]
            const f32x4 pv = dpp_prev4(UP_V(7)), nv = dpp_next4(UP_V(0)), pg = dpp_prev4(UP_G(7)), ng = dpp_next4(UP_G(0));
#pragma unroll
            for (int g = 0; g < 8; ++g) {
                const f32x4 upv = (g == 0) ? pv : UP_V(g == 0 ? 0 : g - 1), unv = (g == 7) ? nv : UP_V(g == 7 ? 7 : g + 1);
                const f32x4 upg = (g == 0) ? pg : UP_G(g == 0 ? 0 : g - 1), ung = (g == 7) ? ng : UP_G(g == 7 ? 7 : g + 1);
                f32x4 cv = w1v * UP_V(g) + bv; cv = w0v * upv + cv; cv = w2v * unv + cv;
                f32x4 cg = w1g * UP_G(g) + bg; cg = w0g * upg + cg; cg = w2g * ung + cg;
                const f32x4 x2 = cg * cg; const f32x4 p = x2 * (0.044715f * GK) + GK; const f32x4 ar = cg * p;
                const f32x4 d = (f32x4){fast_exp2(ar[0]), fast_exp2(ar[1]), fast_exp2(ar[2]), fast_exp2(ar[3])} + 1.0f;
                const f32x4 r = (f32x4){fast_rcp(d[0]), fast_rcp(d[1]), fast_rcp(d[2]), fast_rcp(d[3])};
                const f32x4 o = (cg * r) * cv;
                if (n == 0) { res[g][0] = pk2(o[0], o[1]); res[g][1] = pk2(o[2], o[3]); }
                else { v4u w; w.x = res[g][0]; w.y = res[g][1]; w.z = pk2(o[0], o[1]); w.w = pk2(o[2], o[3]); *(v4u*)(Gout + (size_t)(tok0 + g) * DFF + f0) = w; }
                if (g == 0) { if (fr == 0) { *(f32x4*)(e0p + 4 * n) = cv; *(f32x4*)(e0p + DFF + 4 * n) = cg; *(f32x4*)(e0p + 2 * DFF + 4 * n) = UP_V(0); *(f32x4*)(e0p + 3 * DFF + 4 * n) = UP_G(0); } }
                if (g == 7) { if (fr == 15) { *(f32x4*)(e7p + 4 * n) = cv; *(f32x4*)(e7p + DFF + 4 * n) = cg; *(f32x4*)(e7p + 2 * DFF + 4 * n) = UP_V(7); *(f32x4*)(e7p + 3 * DFF + 4 * n) = UP_G(7); } }
            }
#undef UP_V
#undef UP_G
        }
    }
};
}

struct Frame {
    LAS unsigned char* lds;
    int tid, lane, wave, vcu, G;
    const float* xp; const float* xs; const float* cp; const float* cs;
    const float *w_ada, *b_ada, *g_mix_pre, *g_mix_post, *g_ffn_pre, *g_ffn_post, *w_in, *rpb, *w_a, *w_b, *w_out, *w_up, *conv_w, *conv_b, *w_down;
    float* out; unsigned char* ws;
    float* mod; float* rope; float* lse; float* edge;
    bf16 *Win_t, *Wab_t, *Wout_t, *Wup_t, *Wdn_t, *H, *QKV, *GATE;
};
__device__ __forceinline__ const float* x_row(const Frame& F, int m) { return (m < NSEQ_P * SEQ) ? F.xp + (size_t)m * DM : F.xs + (size_t)(m - NSEQ_P * SEQ) * DM; }

template <bool ROPEPERM>
__device__ __forceinline__ void p0_transpose_item(const float* W, int K, int N, bf16* WT, int ldk, int koff, LAS float* scr, int item, int lane) {
    const int nblk = N / 32, kb = item / nblk, nb = item % nblk, k0 = 64 * kb, n0 = 32 * nb;
    float wv[32];
#pragma unroll
    for (int i = 0; i < 32; ++i) wv[i] = W[(size_t)(k0 + 2 * i + (lane >> 5)) * N + n0 + (lane & 31)];
#pragma unroll
    for (int i = 0; i < 32; ++i) scr[(2 * i + (lane >> 5)) * 33 + (lane & 31)] = wv[i];
    asm volatile("s_waitcnt lgkmcnt(0)" ::: "memory");
    const int c = lane & 7;
#pragma unroll
    for (int j = 0; j < 4; ++j) { const int n = (lane >> 3) + 8 * j; const LAS float* s = scr + (8 * c) * 33 + n;
        v4u o; o.x = pk2(s[0 * 33], s[1 * 33]); o.y = pk2(s[2 * 33], s[3 * 33]); o.z = pk2(s[4 * 33], s[5 * 33]); o.w = pk2(s[6 * 33], s[7 * 33]);
        int dn = n0 + n;
        if (ROPEPERM) { if (dn < 1024) dn = (dn & ~12) | ((dn & 4) << 1) | ((dn & 8) >> 1);
                        else if (dn >= NQKV) { const int g_ = dn - NQKV, ty = g_ >> 10, c_ = g_ & 1023; dn = NQKV + (c_ >> 7) * 256 + ty * 128 + (c_ & 127); } }
        *(v4u*)(WT + (size_t)dn * ldk + koff + k0 + 8 * c) = o; }
    asm volatile("s_waitcnt lgkmcnt(0)" ::: "memory");
}

__device__ __forceinline__ void p0_mod_item(Frame& F, int item) {
    LAS float* sc = (LAS float*)(F.lds) + F.wave * 3072;
    const int k0 = 128 * F.wave, e0 = 32 * item, hh = F.lane >> 5, col = F.lane & 31;
#pragma unroll
    for (int b16 = 0; b16 < 3; ++b16) { float cv[16];
#pragma unroll
        for (int i = 0; i < 16; ++i) { const int idx = F.lane + 64 * (16 * b16 + i), s = idx >> 7, kk = idx & 127;
            cv[i] = (s < NSEQ_P) ? F.cp[s * DM + k0 + kk] : F.cs[(s - NSEQ_P) * DM + k0 + kk]; }
#pragma unroll
        for (int i = 0; i < 16; ++i) { const int idx = F.lane + 64 * (16 * b16 + i); sc[idx] = cv[i] / (1.0f + __expf(-cv[i])); } }
    float acc[24];
#pragma unroll
    for (int s = 0; s < 24; ++s) acc[s] = 0.f;
    const float* wp = F.w_ada + (size_t)(k0 + 64 * hh) * NMOD + e0 + col;
#pragma unroll
    for (int c16 = 0; c16 < 4; ++c16) {
        float w[16];
#pragma unroll
        for (int i = 0; i < 16; ++i) w[i] = wp[(size_t)(16 * c16 + i) * NMOD];
        asm volatile("s_waitcnt lgkmcnt(0)" ::: "memory");
#pragma unroll
        for (int k4 = 0; k4 < 4; ++k4) {
#pragma unroll
            for (int s = 0; s < 24; ++s) { const f32x4 v = *(const LAS f32x4*)(sc + s * 128 + 64 * hh + 16 * c16 + 4 * k4);
                acc[s] += v[0] * w[4 * k4] + v[1] * w[4 * k4 + 1] + v[2] * w[4 * k4 + 2] + v[3] * w[4 * k4 + 3]; }
        }
    }
    asm volatile("s_waitcnt lgkmcnt(0)" ::: "memory");
#pragma unroll
    for (int s = 0; s < 24; ++s) sc[s * 64 + F.lane] = acc[s];
    __syncthreads();
    for (int o = F.tid; o < 24 * 32; o += 512) { const int s = o >> 5, c = o & 31; float v = F.b_ada[e0 + c];
#pragma unroll
        for (int w = 0; w < 8; ++w) v += ((LAS float*)F.lds)[w * 3072 + s * 64 + c] + ((LAS float*)F.lds)[w * 3072 + s * 64 + 32 + c];
        F.mod[s * NMOD + e0 + c] = v; }
    __syncthreads();
}

__device__ __forceinline__ void phase_prologue(Frame& F) {
    const int gw = F.vcu * 8 + F.wave, NGW = F.G * 8;
    if (F.G >= 192 && F.vcu >= F.G - 192) p0_mod_item(F, F.vcu - (F.G - 192));
    else if (F.G < 192) { for (int it = F.vcu; it < 192; it += F.G) p0_mod_item(F, it); }
    for (int e = gw * 64 + F.lane; e < SEQ * 8; e += NGW * 64) { const int pos = e >> 3, i = e & 7;
        const float inv = powf(500000.0f, -(float)i / 8.0f); const float ang = (float)pos * inv;
        F.rope[2 * e] = cosf(ang); F.rope[2 * e + 1] = sinf(ang); }
    LAS float* scr = (LAS float*)(F.lds) + F.wave * 4096;
    constexpr int I_IN = (DM / 64) * (NIN / 32), I_A = (512 / 64) * (DM / 32), I_O = (DM / 64) * (DM / 32), I_UP = (DM / 64) * (NUP / 32), I_DN = (DFF / 64) * (DM / 32);
    constexpr int NITEMS = I_IN + 2 * I_A + I_O + I_UP + I_DN;
    for (int it = gw; it < NITEMS; it += NGW) {
        int r = it;
        if (r < I_IN) { p0_transpose_item<true>(F.w_in, DM, NIN, F.Win_t, DM, 0, scr, r, F.lane); continue; } r -= I_IN;
        if (r < I_A) { p0_transpose_item<false>(F.w_a, 512, DM, F.Wab_t, DM, 0, scr, r, F.lane); continue; } r -= I_A;
        if (r < I_A) { p0_transpose_item<false>(F.w_b, 512, DM, F.Wab_t, DM, 512, scr, r, F.lane); continue; } r -= I_A;
        if (r < I_O) { p0_transpose_item<false>(F.w_out, DM, DM, F.Wout_t, DM, 0, scr, r, F.lane); continue; } r -= I_O;
        if (r < I_UP) { p0_transpose_item<false>(F.w_up, DM, NUP, F.Wup_t, DM, 0, scr, r, F.lane); continue; } r -= I_UP;
        p0_transpose_item<false>(F.w_down, DFF, DM, F.Wdn_t, DFF, 0, scr, r, F.lane);
    }
}

constexpr int ROWS_PER_CHUNK = 24;
__device__ __forceinline__ float sumsq4(const f32x4 (&v)[4]) { float s = 0.f;
#pragma unroll
    for (int j = 0; j < 4; ++j) s += (v[j].x * v[j].x + v[j].y * v[j].y) + (v[j].z * v[j].z + v[j].w * v[j].w);
    return s; }
__device__ __forceinline__ void ld_f32row(f32x4 (&v)[4], const float* row, int lane) { const f32x4* p = (const f32x4*)row + lane;
#pragma unroll
    for (int j = 0; j < 4; ++j) v[j] = p[64 * j]; }
__device__ __forceinline__ void ld_bf16row(v2u (&v)[4], const bf16* row, int lane) { const v2u* p = (const v2u*)row + lane;
#pragma unroll
    for (int j = 0; j < 4; ++j) v[j] = p[64 * j]; }
__device__ __forceinline__ void cvt_bf16row(f32x4 (&o)[4], const v2u (&v)[4]) {
#pragma unroll
    for (int j = 0; j < 4; ++j) o[j] = (f32x4){bf_lo(v[j].x), bf_hi(v[j].x), bf_lo(v[j].y), bf_hi(v[j].y)}; }
__device__ __forceinline__ void st_bf16row(bf16* row, const f32x4 (&o)[4], int lane) { unsigned long long* p = (unsigned long long*)row + lane;
#pragma unroll
    for (int j = 0; j < 4; ++j) p[64 * j] = (unsigned long long)pk2(o[j].x, o[j].y) | ((unsigned long long)pk2(o[j].z, o[j].w) << 32); }
__device__ __forceinline__ void st_f32row(float* row, const f32x4 (&o)[4], int lane) { f32x4* p = (f32x4*)row + lane;
#pragma unroll
    for (int j = 0; j < 4; ++j) p[64 * j] = o[j]; }

__device__ __forceinline__ void phase_h(Frame& F) {
    const int gw = F.vcu * 8 + F.wave, NGW = F.G * 8;
    for (int ch = gw; ch < MTOK / ROWS_PER_CHUNK; ch += NGW) {
        const int m0 = ch * ROWS_PER_CHUNK; int cur_s = -1;
        f32x4 B0[4], SH[4];
        f32x4 xa[2][4], xb[2][4];
        ld_f32row(xa[0], x_row(F, m0), F.lane); ld_f32row(xa[1], x_row(F, m0 + 1), F.lane);
#define H_COMPUTE(X, mm) do { const int s_ = (mm) / SEQ; \
            if (s_ != cur_s) { cur_s = s_; const float* md = F.mod + (size_t)s_ * NMOD; \
                _Pragma("unroll") for (int j = 0; j < 4; ++j) { const int c = 4 * F.lane + 256 * j; \
                    B0[j] = *(const f32x4*)(F.g_mix_pre + c) * (*(const f32x4*)(md + DM + c) + 1.0f); SH[j] = *(const f32x4*)(md + c); } } \
            float q0 = sumsq4(X[0]), q1 = sumsq4(X[1]); \
            _Pragma("unroll") for (int o = 1; o < 64; o <<= 1) { q0 += __shfl_xor(q0, o); q1 += __shfl_xor(q1, o); } \
            const float r0 = 1.0f / sqrtf(q0 * (1.0f / DM) + EPS), r1 = 1.0f / sqrtf(q1 * (1.0f / DM) + EPS); \
            f32x4 o0[4], o1[4]; \
            _Pragma("unroll") for (int j = 0; j < 4; ++j) { o0[j] = X[0][j] * r0 * B0[j] + SH[j]; o1[j] = X[1][j] * r1 * B0[j] + SH[j]; } \
            st_bf16row(F.H + (size_t)(mm) * DM, o0, F.lane); st_bf16row(F.H + (size_t)((mm) + 1) * DM, o1, F.lane); } while (0)
        for (int p = 0; p < ROWS_PER_CHUNK; p += 4) {
            ld_f32row(xb[0], x_row(F, m0 + p + 2), F.lane); ld_f32row(xb[1], x_row(F, m0 + p + 3), F.lane);
            H_COMPUTE(xa, m0 + p);
            if (p + 4 < ROWS_PER_CHUNK) { ld_f32row(xa[0], x_row(F, m0 + p + 4), F.lane); ld_f32row(xa[1], x_row(F, m0 + p + 5), F.lane); }
            H_COMPUTE(xb, m0 + p + 2);
        }
#undef H_COMPUTE
    }
}
__device__ __forceinline__ void phase_mid(Frame& F, const bf16* mix) {
    bf16* X1 = (bf16*)(F.ws + WS_X1);
    const int gw = F.vcu * 8 + F.wave, NGW = F.G * 8;
    for (int ch = gw; ch < MTOK / ROWS_PER_CHUNK; ch += NGW) {
        const int m0 = ch * ROWS_PER_CHUNK; int cur_s = -1;
        f32x4 A1[4], B1[4], SH[4];
        f32x4 xa[2][4], xb[2][4]; v2u ma[2][4], mb[2][4];
        ld_f32row(xa[0], x_row(F, m0), F.lane); ld_f32row(xa[1], x_row(F, m0 + 1), F.lane);
        ld_bf16row(ma[0], mix + (size_t)m0 * DM, F.lane); ld_bf16row(ma[1], mix + (size_t)(m0 + 1) * DM, F.lane);
#define M_COMPUTE(X, MX, mm) do { const int s_ = (mm) / SEQ; \
            if (s_ != cur_s) { cur_s = s_; const float* md = F.mod + (size_t)s_ * NMOD; \
                _Pragma("unroll") for (int j = 0; j < 4; ++j) { const int c = 4 * F.lane + 256 * j; \
                    A1[j] = *(const f32x4*)(F.g_mix_post + c) * *(const f32x4*)(md + 2 * DM + c); \
                    B1[j] = *(const f32x4*)(F.g_ffn_pre + c) * (*(const f32x4*)(md + 4 * DM + c) + 1.0f); SH[j] = *(const f32x4*)(md + 3 * DM + c); } } \
            f32x4 a0[4], a1[4]; cvt_bf16row(a0, MX[0]); cvt_bf16row(a1, MX[1]); \
            float q0 = sumsq4(a0), q1 = sumsq4(a1); \
            _Pragma("unroll") for (int o = 1; o < 64; o <<= 1) { q0 += __shfl_xor(q0, o); q1 += __shfl_xor(q1, o); } \
            const float r0 = 1.0f / sqrtf(q0 * (1.0f / DM) + EPS), r1 = 1.0f / sqrtf(q1 * (1.0f / DM) + EPS); \
            _Pragma("unroll") for (int j = 0; j < 4; ++j) { a0[j] = X[0][j] + A1[j] * (a0[j] * r0); a1[j] = X[1][j] + A1[j] * (a1[j] * r1); } \
            st_bf16row(X1 + (size_t)(mm) * DM, a0, F.lane); st_bf16row(X1 + (size_t)((mm) + 1) * DM, a1, F.lane); \
            q0 = sumsq4(a0); q1 = sumsq4(a1); \
            _Pragma("unroll") for (int o = 1; o < 64; o <<= 1) { q0 += __shfl_xor(q0, o); q1 += __shfl_xor(q1, o); } \
            const float t0 = 1.0f / sqrtf(q0 * (1.0f / DM) + EPS), t1 = 1.0f / sqrtf(q1 * (1.0f / DM) + EPS); \
            _Pragma("unroll") for (int j = 0; j < 4; ++j) { a0[j] = a0[j] * t0 * B1[j] + SH[j]; a1[j] = a1[j] * t1 * B1[j] + SH[j]; } \
            st_bf16row(F.H + (size_t)(mm) * DM, a0, F.lane); st_bf16row(F.H + (size_t)((mm) + 1) * DM, a1, F.lane); } while (0)
        for (int p = 0; p < ROWS_PER_CHUNK; p += 4) {
            ld_f32row(xb[0], x_row(F, m0 + p + 2), F.lane); ld_f32row(xb[1], x_row(F, m0 + p + 3), F.lane);
            ld_bf16row(mb[0], mix + (size_t)(m0 + p + 2) * DM, F.lane); ld_bf16row(mb[1], mix + (size_t)(m0 + p + 3) * DM, F.lane);
            M_COMPUTE(xa, ma, m0 + p);
            if (p + 4 < ROWS_PER_CHUNK) { ld_f32row(xa[0], x_row(F, m0 + p + 4), F.lane); ld_f32row(xa[1], x_row(F, m0 + p + 5), F.lane);
                ld_bf16row(ma[0], mix + (size_t)(m0 + p + 4) * DM, F.lane); ld_bf16row(ma[1], mix + (size_t)(m0 + p + 5) * DM, F.lane); }
            M_COMPUTE(xb, mb, m0 + p + 2);
        }
#undef M_COMPUTE
    }
}
__device__ __forceinline__ void phase_final(Frame& F, const bf16* ffn) {
    const bf16* X1 = (const bf16*)(F.ws + WS_X1);
    const int gw = F.vcu * 8 + F.wave, NGW = F.G * 8;
    for (int ch = gw; ch < MTOK / ROWS_PER_CHUNK; ch += NGW) {
        const int m0 = ch * ROWS_PER_CHUNK; int cur_s = -1;
        f32x4 A2[4];
        v2u xa[2][4], xb[2][4]; v2u ma[2][4], mb[2][4];
        ld_bf16row(xa[0], X1 + (size_t)m0 * DM, F.lane); ld_bf16row(xa[1], X1 + (size_t)(m0 + 1) * DM, F.lane);
        ld_bf16row(ma[0], ffn + (size_t)m0 * DM, F.lane); ld_bf16row(ma[1], ffn + (size_t)(m0 + 1) * DM, F.lane);
#define F_COMPUTE(X, MX, mm) do { const int s_ = (mm) / SEQ; \
            if (s_ != cur_s) { cur_s = s_; const float* md = F.mod + (size_t)s_ * NMOD; \
                _Pragma("unroll") for (int j = 0; j < 4; ++j) { const int c = 4 * F.lane + 256 * j; \
                    A2[j] = *(const f32x4*)(F.g_ffn_post + c) * *(const f32x4*)(md + 5 * DM + c); } } \
            f32x4 a0[4], a1[4], x0[4], x1_[4]; cvt_bf16row(a0, MX[0]); cvt_bf16row(a1, MX[1]); cvt_bf16row(x0, X[0]); cvt_bf16row(x1_, X[1]); \
            float q0 = sumsq4(a0), q1 = sumsq4(a1); \
            _Pragma("unroll") for (int o = 1; o < 64; o <<= 1) { q0 += __shfl_xor(q0, o); q1 += __shfl_xor(q1, o); } \
            const float r0 = 1.0f / sqrtf(q0 * (1.0f / DM) + EPS), r1 = 1.0f / sqrtf(q1 * (1.0f / DM) + EPS); \
            _Pragma("unroll") for (int j = 0; j < 4; ++j) { a0[j] = x0[j] + A2[j] * (a0[j] * r0); a1[j] = x1_[j] + A2[j] * (a1[j] * r1); } \
            st_f32row(F.out + (size_t)(mm) * DM, a0, F.lane); st_f32row(F.out + (size_t)((mm) + 1) * DM, a1, F.lane); } while (0)
        for (int p = 0; p < ROWS_PER_CHUNK; p += 4) {
            ld_bf16row(xb[0], X1 + (size_t)(m0 + p + 2) * DM, F.lane); ld_bf16row(xb[1], X1 + (size_t)(m0 + p + 3) * DM, F.lane);
            ld_bf16row(mb[0], ffn + (size_t)(m0 + p + 2) * DM, F.lane); ld_bf16row(mb[1], ffn + (size_t)(m0 + p + 3) * DM, F.lane);
            F_COMPUTE(xa, ma, m0 + p);
            if (p + 4 < ROWS_PER_CHUNK) { ld_bf16row(xa[0], X1 + (size_t)(m0 + p + 4) * DM, F.lane); ld_bf16row(xa[1], X1 + (size_t)(m0 + p + 5) * DM, F.lane);
                ld_bf16row(ma[0], ffn + (size_t)(m0 + p + 4) * DM, F.lane); ld_bf16row(ma[1], ffn + (size_t)(m0 + p + 5) * DM, F.lane); }
            F_COMPUTE(xb, mb, m0 + p + 2);
        }
#undef F_COMPUTE
    }
}
__device__ __forceinline__ void phase_fixup(Frame& F, bf16* Gout) {
    const int gw = F.vcu * 8 + F.wave, NGW = F.G * 8;
    auto fix = [&](int b, int which) {
        const int tok = 128 * b + (which ? 127 : 0);
        if (which == 0 && (tok & (SEQ - 1)) == 0) return;
        if (which == 1 && (tok & (SEQ - 1)) == SEQ - 1) return;
        const float* P = F.edge + (size_t)(b * 2 + which) * 4 * DFF;
        const float* Nb = which ? F.edge + (size_t)((b + 1) * 2 + 0) * 4 * DFF : F.edge + (size_t)((b - 1) * 2 + 1) * 4 * DFF;
        const float* cwv = F.conv_w + (which ? 2 * NUP : 0);
        for (int c4 = F.lane; c4 < DFF / 4; c4 += 64) { const int c = 4 * c4;
            const f32x4 pv = *(const f32x4*)(P + c), pg = *(const f32x4*)(P + DFF + c), uv = *(const f32x4*)(Nb + 2 * DFF + c), ug = *(const f32x4*)(Nb + 3 * DFF + c);
            const f32x4 wv = *(const f32x4*)(cwv + c), wg = *(const f32x4*)(cwv + DFF + c);
            const f32x4 cv = pv + wv * uv, cg = pg + wg * ug;
            const float o0 = gelu_tanh(cg.x) * cv.x, o1 = gelu_tanh(cg.y) * cv.y, o2 = gelu_tanh(cg.z) * cv.z, o3 = gelu_tanh(cg.w) * cv.w;
            *(v2u*)(Gout + (size_t)tok * DFF + c) = (v2u){pk2(o0, o1), pk2(o2, o3)}; }
    };
    if (F.G == 256) { const int li = (F.vcu & 31) * 8 + F.wave; if (li < 96) fix((F.vcu >> 5) * 48 + (li >> 1), li & 1); }
    else for (int it = gw; it < 384 * 2; it += NGW) fix(it >> 1, it & 1);
}

namespace att {
constexpr int WLDS = 16384;
constexpr int SLOT = 8192, VOFF = 4096, OSTG = 8192, OSTR = 144;
constexpr int RPB_OFF = 8 * WLDS, RPB_STRIDE = 466;
static_assert(RPB_OFF + 8 * RPB_STRIDE * 4 <= MISC_OFF, "attention LDS map");
__device__ __forceinline__ int crow(int r, int hi) { return (r & 3) + 8 * (r >> 2) + 4 * hi; }
__device__ __forceinline__ s16x4 vtr(const LAS unsigned char* p) { typedef short v4i16_t __attribute__((ext_vector_type(4))); return __builtin_bit_cast(s16x4, __builtin_amdgcn_ds_read_tr16_b64_v4i16((LAS v4i16_t*)p)); }

struct State { f32x16 o[2]; float m, l; };

__device__ __forceinline__ unsigned apos(int t) { return (unsigned)((t & 3) * 512 + ((t >> 2) & 3) * 128 + (t >> 4)); }
__device__ __forceinline__ void dma_tile(LAS unsigned char* slot, const char* Kh, const char* Vh, const unsigned (&rb)[4], int lane) {
    const unsigned kc = (unsigned)(((lane & 7) ^ (lane >> 3)) << 4), vc = (unsigned)((lane & 7) << 4);
#pragma unroll
    for (int i = 0; i < 4; ++i) {
        __builtin_amdgcn_global_load_lds((const unsigned*)(Kh + (rb[i] + kc)), (LAS unsigned*)(slot + i * 1024), 16, 0, 0);
        __builtin_amdgcn_global_load_lds((const unsigned*)(Vh + (rb[i] + vc)), (LAS unsigned*)(slot + VOFF + i * 1024), 16, 0, 0); }
}
#define ATT_WAIT_DMA() asm volatile("s_waitcnt vmcnt(0)" ::: "memory")
__device__ __forceinline__ f32x16 qk(const LAS unsigned char* ks, const bf16x8 (&qf)[4], int r32, int hi) {
    f32x16 p = f32x16{};
    const LAS unsigned char* kr = ks + r32 * 128;
#pragma unroll
    for (int s = 0; s < 4; ++s) { const bf16x8 kf = *(const LAS bf16x8*)(kr + ((((2 * s + hi) ^ (r32 & 7))) << 4)); p = __builtin_amdgcn_mfma_f32_32x32x16_bf16(kf, qf[s], p, 0, 0, 0); }
    return p;
}
constexpr float THR = 8.0f;
__device__ __forceinline__ float xmax2(float v) {
    const auto r = __builtin_amdgcn_permlane32_swap(__float_as_uint(v), __float_as_uint(v), false, false); return fmaxf(__uint_as_float(r[0]), __uint_as_float(r[1])); }
__device__ __forceinline__ float xsum2(float v) {
    const auto r = __builtin_amdgcn_permlane32_swap(__float_as_uint(v), __float_as_uint(v), false, false); return __uint_as_float(r[0]) + __uint_as_float(r[1]); }
__device__ __forceinline__ void softmax_blk(State& st, f32x16& p, bf16x8& pa0, bf16x8& pa1, bool fresh_first) {
    float rm = fmaxf(fmaxf(p[0], p[1]), p[2]);
#pragma unroll
    for (int r = 3; r < 15; r += 2) rm = fmaxf(fmaxf(rm, p[r]), p[r + 1]);
    rm = fmaxf(rm, p[15]);
    rm = xmax2(rm);
    if (fresh_first || __any(rm > THR)) {
        const float delta = fresh_first ? ((rm > -1e29f) ? rm : 0.f) : fmaxf(rm, 0.f);
        const float f = fast_exp2(-delta);
        st.m += delta; st.l *= f;
#pragma unroll
        for (int r = 0; r < 16; ++r) { p[r] -= delta; st.o[0][r] *= f; st.o[1][r] *= f; }
    }
    float rs0 = 0.f, rs1 = 0.f;
#pragma unroll
    for (int r = 0; r < 16; r += 2) { p[r] = fast_exp2(p[r]); p[r + 1] = fast_exp2(p[r + 1]); rs0 += p[r]; rs1 += p[r + 1]; }
    st.l += rs0 + rs1;
    v4u pw0, pw1;
    pw0.x = pk2(p[0], p[1]); pw0.y = pk2(p[2], p[3]); pw0.z = pk2(p[4], p[5]); pw0.w = pk2(p[6], p[7]);
    pw1.x = pk2(p[8], p[9]); pw1.y = pk2(p[10], p[11]); pw1.z = pk2(p[12], p[13]); pw1.w = pk2(p[14], p[15]);
    pa0 = __builtin_bit_cast(bf16x8, pw0); pa1 = __builtin_bit_cast(bf16x8, pw1);
}
__device__ __forceinline__ void pv2(State& s0, State& s1, const bf16x8 (&pa)[2][2], const LAS unsigned char* vs, int lane, int hi) {
    const LAS unsigned char* vb = vs + (4 * hi + ((lane & 15) >> 2)) * 128 + (((lane >> 4) & 1) * 16 + (lane & 3) * 4) * 2;
    s16x4 lo[2][2], hh[2][2];
#pragma unroll
    for (int dh = 0; dh < 2; ++dh)
#pragma unroll
        for (int s = 0; s < 2; ++s) { lo[dh][s] = vtr(vb + s * 2048 + dh * 64); hh[dh][s] = vtr(vb + s * 2048 + 1024 + dh * 64); }
    __builtin_amdgcn_sched_barrier(0);
#pragma unroll
    for (int dh = 0; dh < 2; ++dh)
#pragma unroll
        for (int s = 0; s < 2; ++s) {
            const bf16x8 vf = (bf16x8){lo[dh][s][0], lo[dh][s][1], lo[dh][s][2], lo[dh][s][3], hh[dh][s][0], hh[dh][s][1], hh[dh][s][2], hh[dh][s][3]};
            s0.o[dh] = __builtin_amdgcn_mfma_f32_32x32x16_bf16(vf, pa[0][s], s0.o[dh], 0, 0, 0);
            s1.o[dh] = __builtin_amdgcn_mfma_f32_32x32x16_bf16(vf, pa[1][s], s1.o[dh], 0, 0, 0);
        }
}
__device__ __forceinline__ void qk2(f32x16& p0, f32x16& p1, float m0, float m1, const LAS unsigned char* ks, const bf16x8 (&q0)[4], const bf16x8 (&q1)[4], int r32, int hi) {
    const LAS unsigned char* kr = ks + r32 * 128;
    bf16x8 kf[4];
#pragma unroll
    for (int s = 0; s < 4; ++s) kf[s] = *(const LAS bf16x8*)(kr + ((((2 * s + hi) ^ (r32 & 7))) << 4));
#pragma unroll
    for (int r = 0; r < 16; ++r) { p0[r] = -m0; p1[r] = -m1; }
    __builtin_amdgcn_sched_barrier(0);
#pragma unroll
    for (int s = 0; s < 4; ++s) { p0 = __builtin_amdgcn_mfma_f32_32x32x16_bf16(kf[s], q0[s], p0, 0, 0, 0); p1 = __builtin_amdgcn_mfma_f32_32x32x16_bf16(kf[s], q1[s], p1, 0, 0, 0); }
}
template <class TokOf>
__device__ __forceinline__ void finish(State& st, LAS unsigned char* stg, int lane, int hi, bf16* H, unsigned Obase_b, TokOf tok_of, float* lse_ptr  ) {
    const int r32 = lane & 31;
    const float lt = xsum2(st.l);
    const float rl = fast_rcp(lt);
    if (lse_ptr && hi == 0) *lse_ptr = st.m + log2f(lt);
#pragma unroll
    for (int dh = 0; dh < 2; ++dh)
#pragma unroll
        for (int g = 0; g < 4; ++g) { v2u w; w.x = pk2(st.o[dh][4 * g] * rl, st.o[dh][4 * g + 1] * rl); w.y = pk2(st.o[dh][4 * g + 2] * rl, st.o[dh][4 * g + 3] * rl);
            *(LAS v2u*)(stg + r32 * OSTR + (32 * dh + 8 * g + 4 * hi) * 2) = w; }
#pragma unroll
    for (int i = 0; i < 4; ++i) { const int row = i * 8 + (lane >> 3), ch = lane & 7; const v4u v = *(const LAS v4u*)(stg + row * OSTR + ch * 16);
        *(v4u*)((char*)H + (Obase_b + (unsigned)tok_of(row) * (unsigned)(DM * 2) + (unsigned)(ch * 16))) = v; }
}
struct ResumeRaw { v4u row[4]; float lse; };
template <class TokOf>
__device__ __forceinline__ void resume_load(ResumeRaw& R, int lane, const bf16* H, unsigned Obase_b, TokOf tok_of, const float* lse_ptr) {
#pragma unroll
    for (int i = 0; i < 4; ++i) { const int row = i * 8 + (lane >> 3), ch = lane & 7;
        R.row[i] = *(const v4u*)((const char*)H + (Obase_b + (unsigned)tok_of(row) * (unsigned)(DM * 2) + (unsigned)(ch * 16))); }
    R.lse = *lse_ptr;
}
__device__ __forceinline__ void resume_apply(State& st, const ResumeRaw& R, LAS unsigned char* stg, int lane, int hi) {
    const int r32 = lane & 31;
#pragma unroll
    for (int i = 0; i < 4; ++i) { const int row = i * 8 + (lane >> 3), ch = lane & 7; *(LAS v4u*)(stg + row * OSTR + ch * 16) = R.row[i]; }
    st.m = R.lse; st.l = (hi == 0) ? 1.0f : 0.0f;
#pragma unroll
    for (int dh = 0; dh < 2; ++dh)
#pragma unroll
        for (int g = 0; g < 4; ++g) { const v2u w = *(const LAS v2u*)(stg + r32 * OSTR + (32 * dh + 8 * g + 4 * hi) * 2);
            st.o[dh][4 * g] = bf_lo(w.x); st.o[dh][4 * g + 1] = bf_hi(w.x); st.o[dh][4 * g + 2] = bf_lo(w.y); st.o[dh][4 * g + 3] = bf_hi(w.y); }
}

__device__ __forceinline__ void item_dilated(Frame& F, LAS unsigned char* wl, int b, int h, int d, int nb, int idx, bool first, bool lastp) {
    int tid_ = threadIdx.x; asm volatile("" : "+v"(tid_)); asm volatile("" : "+s"(wl));
    const int lane = tid_ & 63, r32 = lane & 31, hi = lane >> 5;
    const int nbp = nb >> 1, r = idx / nbp, jb = 2 * (idx % nbp);
    const size_t tbase = (size_t)b * SEQ + r;
    const bf16* qkv = F.QKV; asm volatile("" : "+s"(qkv));
    constexpr size_t TSZ = (size_t)NSEQ * 8 * SEQ * 64;
    const size_t bh_off = (size_t)(b * 8 + h) * SEQ * 64;
    const char* Qh = (const char*)(qkv + 0 * TSZ + bh_off); const char* Kh = (const char*)(qkv + 1 * TSZ + bh_off); const char* Vh = (const char*)(qkv + 2 * TSZ + bh_off);
    const size_t tq0 = tbase + (size_t)d * (32 * jb + r32), tq1 = tq0 + (size_t)d * 32;
    bf16x8 q0[4], q1[4];
    { const unsigned p0_ = apos(r + d * (32 * jb + r32)) * 128u, p1_ = apos(r + d * (32 * jb + 32 + r32)) * 128u;
#pragma unroll
      for (int s = 0; s < 4; ++s) { q0[s] = *(const bf16x8*)(Qh + p0_ + (16 * s + 8 * hi) * 2); q1[s] = *(const bf16x8*)(Qh + p1_ + (16 * s + 8 * hi) * 2); } }
    const int jt0 = jb - 2 < 0 ? 0 : jb - 2, jt1 = jb + 3 > nb - 1 ? nb - 1 : jb + 3;
#define DIL_DMA(slot_, jj) do { unsigned rb_[4]; _Pragma("unroll") for (int i_ = 0; i_ < 4; ++i_) rb_[i_] = apos(r + d * (32 * (jj) + 8 * i_ + (lane >> 3))) * 128u; dma_tile(slot_, Kh, Vh, rb_, lane); } while (0)
    float* lse0 = F.lse + (unsigned)(tq0 * 8 + h); float* lse1 = F.lse + (unsigned)(tq1 * 8 + h);
    const unsigned tok0 = (unsigned)tbase + (unsigned)(d * 32 * jb);
    auto tok_of0 = [&](int q) { return tok0 + (unsigned)(d * q); };
    auto tok_of1 = [&](int q) { return tok0 + (unsigned)(d * (32 + q)); };
    const unsigned ob = (unsigned)h * 128u;
    ResumeRaw R0, R1;
    if (!first) { resume_load(R0, lane, F.H, ob, tok_of0, lse0); resume_load(R1, lane, F.H, ob, tok_of1, lse1); }
    DIL_DMA(wl + ((jt0 & 1) ? SLOT : 0), jt0);
    State s0, s1;
    if (first) { s0.o[0] = f32x16{}; s0.o[1] = f32x16{}; s0.m = 0.f; s0.l = 0.f; s1 = s0; }
    else { LAS unsigned char* stg = wl + ((jt0 & 1) ? 0 : SLOT);
        resume_apply(s0, R0, stg, lane, hi); asm volatile("s_waitcnt lgkmcnt(0)" ::: "memory"); __builtin_amdgcn_sched_barrier(0);
        resume_apply(s1, R1, stg, lane, hi); asm volatile("s_waitcnt lgkmcnt(0)" ::: "memory"); __builtin_amdgcn_sched_barrier(0); }
    for (int jt = jt0; jt <= jt1; ++jt) {
        LAS unsigned char* ks = wl + ((jt & 1) ? SLOT : 0); LAS unsigned char* vs = ks + VOFF;
        ATT_WAIT_DMA();
        if (jt < jt1) DIL_DMA(wl + ((jt & 1) ? 0 : SLOT), jt + 1);
        f32x16 p0, p1; qk2(p0, p1, s0.m, s1.m, ks, q0, q1, r32, hi);
        const int dt0 = jt - jb, dt1 = dt0 - 1;
#define DIL_MASK(P, DT) do { \
            if ((DT) == -2) { asm volatile("" ::: "memory"); _Pragma("unroll") for (int rr = 0; rr < 16; ++rr) P[rr] = (crow(rr, hi) >= r32) ? P[rr] : -1e30f; } \
            else if ((DT) == 2) { asm volatile("" ::: "memory"); _Pragma("unroll") for (int rr = 0; rr < 16; ++rr) P[rr] = (crow(rr, hi) <= r32) ? P[rr] : -1e30f; } \
            else if ((DT) < -2 || (DT) > 2) { asm volatile("" ::: "memory"); _Pragma("unroll") for (int rr = 0; rr < 16; ++rr) P[rr] = -1e30f; } } while (0)
        DIL_MASK(p0, dt0); DIL_MASK(p1, dt1);
#undef DIL_MASK
        bf16x8 pa[2][2];
        softmax_blk(s0, p0, pa[0][0], pa[0][1], first && jt == jt0); softmax_blk(s1, p1, pa[1][0], pa[1][1], first && jt == jt0);
        pv2(s0, s1, pa, vs, lane, hi);
    }
    finish(s0, wl + OSTG, lane, hi, F.H, ob, tok_of0, lastp ? nullptr : lse0);
    finish(s1, wl + OSTG, lane, hi, F.H, ob, tok_of1, lastp ? nullptr : lse1);
}

__device__ __forceinline__ void item_neigh(Frame& F, LAS unsigned char* wl, const LAS float* rpbL, int b, int h, int idx) {
    int tid_ = threadIdx.x; asm volatile("" : "+v"(tid_)); asm volatile("" : "+s"(wl));
    const int lane = tid_ & 63, r32 = lane & 31, hi = lane >> 5;
    const int rq = idx >> 2, cb = idx & 3;
    const bf16* qkv = F.QKV; asm volatile("" : "+s"(qkv));
    constexpr size_t TSZ = (size_t)NSEQ * 8 * SEQ * 64;
    const size_t bh_off = (size_t)(b * 8 + h) * SEQ * 64;
    const char* Qh = (const char*)(qkv + 3 * TSZ + bh_off); const char* Kh = (const char*)(qkv + 4 * TSZ + bh_off); const char* Vh = (const char*)(qkv + 5 * TSZ + bh_off);
    const int qrow0 = 4 * rq + (r32 >> 4), qrow1 = qrow0 + 2, qcol = 16 * cb + (r32 & 15);
    const size_t sb = (size_t)b * SEQ;
    bf16x8 q0[4], q1[4];
    { const unsigned p0_ = (unsigned)(qrow0 * 64 + qcol) * 128u, p1_ = p0_ + 128u * 128u;
#pragma unroll
      for (int s = 0; s < 4; ++s) { q0[s] = *(const bf16x8*)(Qh + p0_ + (16 * s + 8 * hi) * 2); q1[s] = *(const bf16x8*)(Qh + p1_ + (16 * s + 8 * hi) * 2); } }
    auto clip = [](int v, int lo, int hi_) { return v < lo ? lo : (v > hi_ ? hi_ : v); };
    const int kr0 = clip(4 * rq - 4, 0, 24), krl = clip(4 * rq + 3 - 4, 0, 24) + 7;
    const int rs_0 = clip(qrow0 - 4, 0, 24), rs_1 = clip(qrow1 - 4, 0, 24), my_cs = clip(qcol - 8, 0, 48);
    const int span0 = clip(16 * cb - 8, 0, 32);
    State s0, s1; s0.o[0] = f32x16{}; s0.o[1] = f32x16{}; s0.m = 0.f; s0.l = 0.f; s1 = s0;
    const LAS float* bh = rpbL + h * RPB_STRIDE;
#define NB_DMA(slot_, kk_) do { unsigned rb_[4]; _Pragma("unroll") for (int i_ = 0; i_ < 4; ++i_) rb_[i_] = (unsigned)((kk_) * 64 + span0 + 8 * i_ + (lane >> 3)) * 128u; dma_tile(slot_, Kh, Vh, rb_, lane); } while (0)
    NB_DMA(wl + ((kr0 & 1) ? SLOT : 0), kr0);
    int boff[16];
#pragma unroll
    for (int rr = 0; rr < 16; ++rr) { const int kc = span0 + crow(rr, hi); boff[rr] = (kc >= my_cs && kc < my_cs + 16) ? crow(rr, hi) : 1000; }
    const int cbi = span0 - qcol + 15;
    for (int kr = kr0; kr <= krl; ++kr) {
        LAS unsigned char* ks = wl + ((kr & 1) ? SLOT : 0); LAS unsigned char* vs = ks + VOFF;
        ATT_WAIT_DMA();
        if (kr < krl) NB_DMA(wl + ((kr & 1) ? 0 : SLOT), kr + 1);
        f32x16 p0, p1; qk2(p0, p1, s0.m, s1.m, ks, q0, q1, r32, hi);
        const bool ok0 = (kr >= rs_0) && (kr < rs_0 + 8), ok1 = (kr >= rs_1) && (kr < rs_1 + 8);
        const int b0 = ok0 ? (kr - qrow0 + 7) * 31 + cbi : 1000, b1 = ok1 ? (kr - qrow1 + 7) * 31 + cbi : 1000;
#pragma unroll
        for (int rr = 0; rr < 16; ++rr) { const int i0 = min(b0 + boff[rr], 465), i1 = min(b1 + boff[rr], 465); p0[rr] += bh[i0]; p1[rr] += bh[i1]; }
        bf16x8 pa[2][2];
        softmax_blk(s0, p0, pa[0][0], pa[0][1], kr == kr0); softmax_blk(s1, p1, pa[1][0], pa[1][1], kr == kr0);
        pv2(s0, s1, pa, vs, lane, hi);
    }
    auto tok_of0 = [&](int q) { return (unsigned)sb + (unsigned)((4 * rq + (q >> 4)) * 64 + 16 * cb + (q & 15)); };
    auto tok_of1 = [&](int q) { return (unsigned)sb + (unsigned)((4 * rq + 2 + (q >> 4)) * 64 + 16 * cb + (q & 15)); };
    finish(s0, wl + OSTG, lane, hi, F.H, 1024u + (unsigned)h * 128u, tok_of0, nullptr);
    finish(s1, wl + OSTG, lane, hi, F.H, 1024u + (unsigned)h * 128u, tok_of1, nullptr);
}

__device__ __forceinline__ void phase_attn(Frame& F, int which) {
    LAS unsigned char* wl = F.lds + F.wave * WLDS;
    const int gw = F.vcu * 8 + F.wave, NGW = F.G * 8;
    constexpr int NITEMS = NSEQ * 8 * 32;
    if (which == 0) {
        LAS float* rpbL = (LAS float*)(F.lds + RPB_OFF);
        for (int i = F.tid; i < 8 * RPB_STRIDE; i += 512) { const int hh = i / RPB_STRIDE, e = i - hh * RPB_STRIDE; rpbL[i] = (e < 465) ? F.rpb[hh * 465 + e] * LOG2E : -1e30f; }
        __syncthreads();
        for (int it = gw; it < NITEMS; it += NGW) { int bh = it >> 5; const int idx = ((it & 31) + 11 * (it >> 11)) & 31; if (F.G == 256) bh = ((F.vcu >> 5) * 3 + (it >> 11)) * 8 + ((F.vcu & 31) >> 2);     item_neigh(F, wl, rpbL, bh >> 3, bh & 7, idx); }
        for (int it = gw; it < NITEMS; it += NGW) { int bh = it >> 5; const int idx = ((it & 31) + 11 * (it >> 11)) & 31; if (F.G == 256) bh = ((F.vcu >> 5) * 3 + (it >> 11)) * 8 + ((F.vcu & 31) >> 2);     item_dilated(F, wl, bh >> 3, bh & 7, 1, 64, idx, true, false); }
    } else if (which == 1) {
        for (int it = gw; it < NITEMS; it += NGW) { int bh = it >> 5; const int idx = ((it & 31) + 11 * (it >> 11)) & 31; if (F.G == 256) bh = ((F.vcu >> 5) * 3 + (it >> 11)) * 8 + ((F.vcu & 31) >> 2);     item_dilated(F, wl, bh >> 3, bh & 7, 4, 16, idx, false, false); }
    } else {
        for (int it = gw; it < NITEMS; it += NGW) { int bh = it >> 5; const int idx = ((it & 31) + 11 * (it >> 11)) & 31; if (F.G == 256) bh = ((F.vcu >> 5) * 3 + (it >> 11)) * 8 + ((F.vcu & 31) >> 2);     item_dilated(F, wl, bh >> 3, bh & 7, 16, 4, idx, false, true); }
    }
}
}


#define XB_TMO      128
#define XB_XCNT(j)  (256  + 64 * (j))
#define XB_XSUB(j)  (1280 + 64 * (j))
#define XB_XGEN(j)  (2304 + 64 * (j))
#define XB_TOP      3328
#define XB_TOPGEN   3392
#define XCD_BAR_WORDS 3456
#define XB_SPIN_CAP (1u << 18)
__device__ __forceinline__ unsigned xb_ld(unsigned* p)              { return __hip_atomic_load(p, __ATOMIC_RELAXED, __HIP_MEMORY_SCOPE_AGENT); }
__device__ __forceinline__ unsigned xb_add(unsigned* p, unsigned v) { return __hip_atomic_fetch_add(p, v, __ATOMIC_RELAXED, __HIP_MEMORY_SCOPE_AGENT); }
__device__ __forceinline__ unsigned xb_xcc_id() { return (unsigned)__builtin_amdgcn_s_getreg((3 << 11) | 20) & 0xFu; }
#define XB_SPIN(cond, bar) do { unsigned _sp = 0; while (cond) { __builtin_amdgcn_s_sleep(1); \
    if ((++_sp & 255u) == 0u) { if (xb_ld(&(bar)[XB_TMO])) break; if (_sp > XB_SPIN_CAP) { atomicAdd(&(bar)[XB_TMO], 1u); break; } } } } while (0)
struct XcdBarrier { unsigned* bar; unsigned x; volatile LAS unsigned* st; };
__device__ __forceinline__ XcdBarrier xcd_barrier_post(unsigned* bar, volatile LAS unsigned* st) {
    XcdBarrier b; b.bar = bar; b.x = xb_xcc_id(); b.st = st;
    if (threadIdx.x == 0) (void)xb_add(&bar[XB_XCNT(b.x)], 1u);
    return b;
}
__device__ __forceinline__ void xcd_barrier_complete(unsigned* bar, unsigned x, unsigned& nloc, unsigned& nx) {
    const unsigned G = gridDim.x * gridDim.y * gridDim.z;
    unsigned sum, cnt, mine, sp = 0u;
    for (;;) {
        sum = 0u; cnt = 0u; mine = 0u;
#pragma unroll
        for (unsigned j = 0; j < 16; ++j) { const unsigned c = xb_ld(&bar[XB_XCNT(j)]); sum += c; cnt += (c > 0u) ? 1u : 0u; mine = (j == x) ? c : mine; }
        if (sum == G) break;
        __builtin_amdgcn_s_sleep(1);
        if ((++sp & 255u) == 0u) { if (xb_ld(&bar[XB_TMO])) break; if (sp > XB_SPIN_CAP) { atomicAdd(&bar[XB_TMO], 1u); break; } }
    }
    nloc = mine > 0u ? mine : 1u; nx = cnt > 0u ? cnt : 1u;
}
__device__ __forceinline__ void xcd_barrier(const XcdBarrier& b) {
    asm volatile("s_waitcnt vmcnt(0)" ::: "memory");
    __syncthreads();
    if (threadIdx.x == 0) {
        unsigned* bar = b.bar;
        __builtin_amdgcn_s_waitcnt(0);
        unsigned nloc = b.st[0], nx = b.st[1];
        if (nloc == 0u) { xcd_barrier_complete(bar, b.x, nloc, nx); b.st[0] = nloc; b.st[1] = nx; }
        const unsigned old = xb_add(&bar[XB_XSUB(b.x)], 1u);
        const unsigned gen = old / nloc;
        if (old + 1u == (gen + 1u) * nloc) {
            __builtin_amdgcn_fence(__ATOMIC_RELEASE, "agent");
            asm volatile("s_waitcnt vmcnt(0)" ::: "memory");
            const unsigned og = xb_add(&bar[XB_TOP], 1u);
            const unsigned tg = og / nx;
            if (og + 1u == (tg + 1u) * nx) xb_add(&bar[XB_TOPGEN], 1u);
            else XB_SPIN(xb_ld(&bar[XB_TOPGEN]) == tg, bar);
            __builtin_amdgcn_fence(__ATOMIC_ACQUIRE, "agent");
            xb_add(&bar[XB_XGEN(b.x)], 1u);
            asm volatile("s_waitcnt vmcnt(0)" ::: "memory");
        } else {
            XB_SPIN(xb_ld(&bar[XB_XGEN(b.x)]) == gen, bar);
            __builtin_amdgcn_fence(__ATOMIC_ACQUIRE, "agent");
            asm volatile("s_waitcnt vmcnt(0)" ::: "memory");
        }
    }
    __syncthreads();
}

#define GRP_BAR_WORD(x)  (XCD_BAR_WORDS + 64 * (x))
#define GRP_MASK_WORD(x) (XCD_BAR_WORDS + 64 * (x) + 32)
#define GRP_BAR_WORDS (XCD_BAR_WORDS + 64 * 8)
__device__ __forceinline__ void group_census_post(unsigned* bar) {
    (void)__hip_atomic_fetch_or(&bar[GRP_MASK_WORD(blockIdx.x & 7)], 1u << xb_xcc_id(), __ATOMIC_RELAXED, __HIP_MEMORY_SCOPE_AGENT);
}
__device__ __forceinline__ bool group_census_single(unsigned* bar) {
    const unsigned m = __builtin_amdgcn_readfirstlane(xb_ld(&bar[GRP_MASK_WORD(blockIdx.x & 7)]));
    return m != 0u && (m & (m - 1u)) == 0u;
}
__device__ __forceinline__ void group_barrier(unsigned* bar, unsigned nper, bool one_l2) {
    asm volatile("s_waitcnt vmcnt(0)" ::: "memory");
    __syncthreads();
    if (threadIdx.x == 0) {
        unsigned* c = &bar[GRP_BAR_WORD(blockIdx.x & 7)];
        if (!one_l2) __builtin_amdgcn_fence(__ATOMIC_RELEASE, "agent");
        const unsigned old = xb_add(c, 1u);
        const unsigned target = (old / nper + 1u) * nper;
        XB_SPIN(xb_ld(c) < target, bar);
        if (!one_l2) __builtin_amdgcn_fence(__ATOMIC_ACQUIRE, "agent");
        asm volatile("s_waitcnt vmcnt(0)" ::: "memory");
    }
    __syncthreads();
    if (one_l2) asm volatile("buffer_inv sc0\n\ts_waitcnt vmcnt(0)" ::: "memory");
}

struct Args { const float* in[19]; float* out; unsigned char* ws; int ph_lo, ph_hi, coop, pad; };

#define MK_FRAME(F) Frame F; F.lds = (LAS unsigned char*)lds_raw; F.tid = threadIdx.x; F.lane = F.tid & 63; F.wave = __builtin_amdgcn_readfirstlane(F.tid >> 6); \
    F.G = gridDim.x; { const int bx_ = blockIdx.x; F.vcu = (F.G % 8 == 0) ? (bx_ % 8) * (F.G / 8) + bx_ / 8 : bx_; } \
    F.xp = args.in[0]; F.xs = args.in[1]; F.cp = args.in[2]; F.cs = args.in[3]; F.w_ada = args.in[4]; F.b_ada = args.in[5]; \
    F.g_mix_pre = args.in[6]; F.g_mix_post = args.in[7]; F.g_ffn_pre = args.in[8]; F.g_ffn_post = args.in[9]; F.w_in = args.in[10]; F.rpb = args.in[11]; \
    F.w_a = args.in[12]; F.w_b = args.in[13]; F.w_out = args.in[14]; F.w_up = args.in[15]; F.conv_w = args.in[16]; F.conv_b = args.in[17]; F.w_down = args.in[18]; \
    F.out = args.out; F.ws = args.ws; \
    F.mod = (float*)(args.ws + WS_MOD); F.rope = (float*)(args.ws + WS_ROPE); F.lse = (float*)(args.ws + WS_LSE); F.edge = (float*)(args.ws + WS_EDGE); \
    F.Win_t = (bf16*)(args.ws + WS_WIN); F.Wab_t = (bf16*)(args.ws + WS_WAB); F.Wout_t = (bf16*)(args.ws + WS_WOUT); F.Wup_t = (bf16*)(args.ws + WS_WUP); F.Wdn_t = (bf16*)(args.ws + WS_WDN); \
    F.H = (bf16*)(args.ws + WS_H); F.QKV = (bf16*)(args.ws + WS_QKV); F.GATE = (bf16*)args.out; \
    bf16* MERGED = (bf16*)(args.ws + WS_QKV); bf16* MIX = (bf16*)(args.ws + WS_QKV + 96 * MiB); bf16* GFF = (bf16*)(args.ws + WS_QKV); (void)MERGED; (void)MIX; (void)GFF;

__global__ void __launch_bounds__(512, 2) fwd_kernel(Args args) {
    extern __shared__ __attribute__((aligned(16))) unsigned char lds_raw[];
    unsigned char* ws = args.ws;
    const int lo = args.ph_lo, hi = args.ph_hi; const bool coop = args.coop != 0;
    volatile LAS unsigned* MISC = (volatile LAS unsigned*)((LAS unsigned char*)lds_raw + MISC_OFF);
    if (threadIdx.x < 32) MISC[threadIdx.x] = 0u;
    __syncthreads();
    XcdBarrier bar; bar.bar = (unsigned*)(ws + WS_CTL) + 4096; bar.x = 0; bar.st = nullptr;
    if (coop) bar = xcd_barrier_post((unsigned*)(ws + WS_CTL) + 4096, MISC + 8);
    bool grp_one_l2 = false;
    if (coop && threadIdx.x == 0) group_census_post((unsigned*)(ws + WS_CTL) + 4096);
#ifndef ONLY
#define ONLY -1
#endif
#define IN(k) ((ONLY < 0 || ONLY == (k)) && lo <= (k) && (k) < hi)
#define SEAM(k) do { if (coop && (k) + 1 < hi) { if ((k) == 0 || gridDim.x != 256) { xcd_barrier(bar); if ((k) == 0) grp_one_l2 = group_census_single(bar.bar); } else group_barrier(bar.bar, 32u, grp_one_l2); } } while (0)
#ifndef DUP_MASK
#define DUP_MASK 0
#endif
#define RUN(k, ...) do { if (IN(k)) { { MK_FRAME(F) __VA_ARGS__; } if ((DUP_MASK >> (k)) & 1) { xcd_barrier(bar); { MK_FRAME(F) __VA_ARGS__; } } SEAM(k); } } while (0)
    RUN(0, phase_prologue(F));
    RUN(1, phase_h(F));
    RUN(2, {
        pg8::Gemm g{F.H, F.Win_t, MTOK / 256, NIN / 256, DM, (size_t)256 * DM * 2, (size_t)128 * DM * 2};
        pg8::StaticOrder S; S.init(g.nM, g.nN, F.G, (int)blockIdx.x);
        pg8::EpiQKV E{F.QKV, F.GATE, F.rope};
        pg8::gemm_phase<pg8::EpiQKV, true, false>(F.lds, g, S, E); });
    RUN(3, att::phase_attn(F, 0));
    RUN(4, att::phase_attn(F, 1));
    RUN(5, att::phase_attn(F, 2));
    RUN(6, {
        pg8::Gemm g{F.H, F.Wab_t, MTOK / 256, DM / 256, DM, (size_t)256 * DM * 2, (size_t)128 * DM * 2};
        pg8::StaticOrder S; S.init(g.nM, g.nN, F.G, (int)blockIdx.x);
        pg8::EpiMerged E{F.GATE, MERGED};
        pg8::gemm_phase<pg8::EpiMerged, true, false>(F.lds, g, S, E); });
    RUN(7, {
        pg8::Gemm g{MERGED, F.Wout_t, MTOK / 256, DM / 256, DM, (size_t)256 * DM * 2, (size_t)128 * DM * 2};
        pg8::StaticOrder S; S.init(g.nM, g.nN, F.G, (int)blockIdx.x);
        pg8::EpiBf16 E{MIX, DM};
        pg8::gemm_phase<pg8::EpiBf16, true, false>(F.lds, g, S, E); });
    RUN(8, phase_mid(F, MIX));
    RUN(9, {
        pg8::Gemm g{F.H, F.Wup_t, MTOK / 256, DFF / 128, DM, (size_t)128 * DM * 2, (size_t)DFF * DM * 2};
        pg8::StaticOrder S; S.init(g.nM, g.nN, F.G, (int)blockIdx.x);
        pg8::EpiUp E{GFF, F.edge, F.conv_w, F.conv_b, (LAS float*)(F.lds + RING_BYTES)};
        pg8::gemm_phase<pg8::EpiUp, true, true>(F.lds, g, S, E); });
    RUN(10, phase_fixup(F, GFF));
    RUN(11, {
        pg8::Gemm g{GFF, F.Wdn_t, MTOK / 256, DM / 256, DFF, (size_t)256 * DFF * 2, (size_t)128 * DFF * 2};
        pg8::StaticOrder S; S.init(g.nM, g.nN, F.G, (int)blockIdx.x);
        pg8::EpiBf16 E{F.H, DM};
        pg8::gemm_phase<pg8::EpiBf16, true, false>(F.lds, g, S, E); });
    RUN(12, phase_final(F, F.H));
#undef RUN
#undef IN
#undef SEAM
}

extern "C" void kernel_launch(void* const* d_in, const int* in_sizes, int n_in, void* d_out, int out_size, void* d_ws, size_t ws_size, hipStream_t stream) {
    static int grid = 0;
    if (grid == 0) {
        if (n_in != 19 || out_size != MTOK * DM || ws_size < WS_END) { fprintf(stderr, "kernel_launch: unexpected sizes n_in %d out %d ws %zu\n", n_in, out_size, ws_size); grid = -1; return; }
        int dev = 0, cus = 0, per_cu = 0;
        (void)hipGetDevice(&dev); (void)hipDeviceGetAttribute(&cus, hipDeviceAttributeMultiprocessorCount, dev);
        if (hipFuncSetAttribute((const void*)fwd_kernel, hipFuncAttributeMaxDynamicSharedMemorySize, LDS_BYTES) != hipSuccess) { fprintf(stderr, "kernel_launch: hipFuncSetAttribute failed\n"); grid = -1; return; }
        if (hipOccupancyMaxActiveBlocksPerMultiprocessor(&per_cu, (const void*)fwd_kernel, 512, LDS_BYTES) != hipSuccess || per_cu < 1) { fprintf(stderr, "kernel_launch: occupancy query says %d\n", per_cu); per_cu = 1; }
        (void)hipGetLastError();
        grid = cus;
    }
    if (grid < 0) return;
    (void)hipMemsetAsync((char*)d_ws + WS_CTL + 4096 * 4, 0, GRP_BAR_WORDS * 4, stream);
    Args a{};
    for (int i = 0; i < 19; ++i) a.in[i] = (const float*)d_in[i];
    a.out = (float*)d_out; a.ws = (unsigned char*)d_ws;
#if N_LAUNCH_MODE == 1
    a.ph_lo = 0; a.ph_hi = NPH; a.coop = 1;
    void* kargs[] = {&a};
    hipError_t e = hipLaunchCooperativeKernel((const void*)fwd_kernel, dim3(grid), dim3(512), kargs, LDS_BYTES, stream);
    if (e != hipSuccess) fprintf(stderr, "cooperative launch failed: %s (grid %d)\n", hipGetErrorString(e), grid);
#else
    for (int p = 0; p < NPH; ++p) { a.ph_lo = p; a.ph_hi = p + 1; a.coop = 0;
        hipLaunchKernelGGL(fwd_kernel, dim3(grid), dim3(512), LDS_BYTES, stream, a); }
#endif
}
```
